# Optimizing an MI355X kernel written in HIP

```python
import math
import jax
import jax.numpy as jnp
from jax import lax
import numpy as np


D_MODEL = 1024
BATCH = 2
SEQ = 8192
DEPTH = 2

GRID_W = 64
CTX_LEN = 256
HEAD_DIM = 64
MIX_W = D_MODEL
Q_BLOCK = 128
ROPE_THETA = 10000.0
DIFF_HEADS = MIX_W // 2 // (2 * HEAD_DIM)
DIFF_QK = DIFF_HEADS * 2 * HEAD_DIM
DIFF_V = DIFF_HEADS * 2 * HEAD_DIM
GQA_HEADS = MIX_W // 2 // HEAD_DIM
GQA_KV_HEADS = max(1, GQA_HEADS // 4)
GQA_GROUP = GQA_HEADS // GQA_KV_HEADS
GQA_Q = GQA_HEADS * HEAD_DIM
GQA_KV_W = GQA_KV_HEADS * HEAD_DIM
AB_Q = DIFF_QK + GQA_Q
AB_KV = DIFF_QK + DIFF_V + 2 * GQA_KV_W
AB_OUT = DIFF_V + GQA_Q
WINDOW = 128
WIN_HEADS = MIX_W // 2 // HEAD_DIM
WIN_KV_HEADS = max(1, WIN_HEADS // 4)
WIN_GROUP = WIN_HEADS // WIN_KV_HEADS
WIN_Q = WIN_HEADS * HEAD_DIM
WIN_KV_W = WIN_KV_HEADS * HEAD_DIM
NA_HEADS = MIX_W // 2 // HEAD_DIM
NA_W = NA_HEADS * HEAD_DIM
NA_ROWS_MAX = 8
NA_COLS = 16
CD_Q = WIN_Q + NA_W
CD_KV = 2 * WIN_KV_W + 2 * NA_W
CD_OUT = WIN_Q + NA_W
N_GROUPS = 4
EXPERTS_PER_GROUP = 8
N_EXPERTS = N_GROUPS * EXPERTS_PER_GROUP
TOP_K_IN_GROUP = 2
D_EXPERT = D_MODEL // 2
MOE_BLOCK = 128
N_EVEN = (DEPTH + 1) // 2
N_ODD = DEPTH // 2
ALPHA = (2.0 * DEPTH) ** 0.25
BETA = (8.0 * DEPTH) ** -0.25
LN_EPS = 1e-5
RMS_EPS = 1e-6
ATTN_SCALE = HEAD_DIM ** -0.5
NEG_INF = -1e30

kernel_name = 'hybrid_flow_backbone'


def layer_norm(x, g, b):
    xf = x.astype(jnp.float32)
    mu = jnp.mean(xf, -1, keepdims=True)
    var = jnp.mean(jnp.square(xf - mu), -1, keepdims=True)
    y = (xf - mu) * lax.rsqrt(var + LN_EPS) * g.astype(jnp.float32) + b.astype(jnp.float32)
    return y.astype(x.dtype)


def rms_norm(x, g):
    xf = x.astype(jnp.float32)
    y = xf * lax.rsqrt(jnp.mean(jnp.square(xf), -1, keepdims=True) + RMS_EPS) * g.astype(jnp.float32)
    return y.astype(x.dtype)


def modulate(x, shift, scale):
    return x * (1.0 + scale) + shift


def lambda_init(layer_idx):
    return 0.8 - 0.6 * math.exp(-0.3 * layer_idx)


def axial_rope_tables(n_tokens):
    t = jnp.arange(n_tokens, dtype=jnp.int32)
    row = (t // GRID_W).astype(jnp.float32)
    col = (t % GRID_W).astype(jnp.float32)
    n_freq = HEAD_DIM // 4
    inv = ROPE_THETA ** (-jnp.arange(n_freq, dtype=jnp.float32) / n_freq)
    ang = jnp.concatenate([row[:, None] * inv, col[:, None] * inv], -1)
    return jnp.cos(ang), jnp.sin(ang)


def apply_rope(x, cos, sin):
    shp = (1, cos.shape[0]) + (1,) * (x.ndim - 3) + (cos.shape[1],)
    cos = cos.reshape(shp)
    sin = sin.reshape(shp)
    xf = x.astype(jnp.float32)
    x1, x2 = jnp.split(xf, 2, -1)
    return jnp.concatenate([x1 * cos - x2 * sin, x2 * cos + x1 * sin], -1).astype(x.dtype)


def sweep_query_blocks(fn, q):
    b, s = q.shape[:2]
    nb = s // Q_BLOCK
    qb = jnp.moveaxis(q.reshape((b, nb, Q_BLOCK) + q.shape[2:]), 1, 0)
    out = lax.map(lambda a: fn(a[0], a[1]), (jnp.arange(nb, dtype=jnp.int32), qb))
    out = jnp.moveaxis(out, 0, 1)
    return out.reshape((b, s) + out.shape[3:])


def diff_attend(qb, k, v, lam):
    s = jnp.einsum('bqhcd,bkhcd->bhcqk', qb, k).astype(jnp.float32) * ATTN_SCALE
    p = jax.nn.softmax(s, -1)
    a = p[:, :, 0] - lam * p[:, :, 1]
    return jnp.einsum('bhqk,bkhe->bqhe', a.astype(v.dtype), v)


def gqa_attend(qb, k, v):
    s = jnp.einsum('bqhgd,bkhd->bhgqk', qb, k).astype(jnp.float32) * ATTN_SCALE
    p = jax.nn.softmax(s, -1)
    return jnp.einsum('bhgqk,bkhd->bqhgd', p.astype(v.dtype), v)


def sink_attend(qb, k, v, sink, valid=None):
    s = jnp.einsum('bqhgd,bkhd->bhgqk', qb, k).astype(jnp.float32) * ATTN_SCALE
    if valid is not None:
        s = jnp.where(valid, s, NEG_INF)
    sk = jnp.broadcast_to(sink.astype(jnp.float32)[None, :, :, None, None], s.shape[:-1] + (1,))
    p = jax.nn.softmax(jnp.concatenate([s, sk], -1), -1)[..., :-1]
    return jnp.einsum('bhgqk,bkhd->bqhgd', p.astype(v.dtype), v)


def window_attention(q, k, v, kc, vc, sink):
    s = q.shape[1]
    n_ctx = kc.shape[1]
    span = Q_BLOCK + 2 * WINDOW
    pad = ((0, 0), (WINDOW, WINDOW), (0, 0), (0, 0))
    kp = jnp.pad(k, pad)
    vp = jnp.pad(v, pad)
    ctx_valid = jnp.ones((Q_BLOCK, n_ctx), dtype=bool)

    def block(bi, qb):
        start = bi * Q_BLOCK
        kb = lax.dynamic_slice_in_dim(kp, start, span, axis=1)
        vb = lax.dynamic_slice_in_dim(vp, start, span, axis=1)
        qpos = start + jnp.arange(Q_BLOCK)
        kpos = start - WINDOW + jnp.arange(span)
        local = (jnp.abs(qpos[:, None] - kpos[None, :]) <= WINDOW) & (kpos >= 0)[None, :] & (kpos < s)[None, :]
        valid = jnp.concatenate([local, ctx_valid], 1)
        return sink_attend(qb, jnp.concatenate([kb, kc], 1), jnp.concatenate([vb, vc], 1), sink, valid)

    return sweep_query_blocks(block, q)


def neighbourhood_attention(q, k, v, kc, vc, rpb):
    b, s, h, d = q.shape
    rows = s // GRID_W
    kr = min(NA_ROWS_MAX, rows)
    n_nb = kr * NA_COLS
    qg = jnp.moveaxis(q.reshape(b, rows, GRID_W, h, d), 1, 0)
    kg = k.reshape(b, rows, GRID_W, h, d)
    vg = v.reshape(b, rows, GRID_W, h, d)
    col = jnp.arange(GRID_W)
    col_start = jnp.clip(col - NA_COLS // 2, 0, GRID_W - NA_COLS)
    cols = col_start[:, None] + jnp.arange(NA_COLS)
    col_off = cols - col[:, None] + (NA_COLS - 1)

    def row_block(a):
        r, qr = a
        r0 = jnp.clip(r - kr // 2, 0, rows - kr)
        slab_k = lax.dynamic_slice_in_dim(kg, r0, kr, axis=1)
        slab_v = lax.dynamic_slice_in_dim(vg, r0, kr, axis=1)
        k_nb = jnp.moveaxis(slab_k[:, :, cols], 1, 2).reshape(b, GRID_W, n_nb, h, d)
        v_nb = jnp.moveaxis(slab_v[:, :, cols], 1, 2).reshape(b, GRID_W, n_nb, h, d)
        row_off = r0 + jnp.arange(kr) - r + (NA_ROWS_MAX - 1)
        bias = rpb[:, row_off[None, :, None], col_off[:, None, :]].reshape(h, GRID_W, n_nb)
        s_nb = jnp.einsum('bqhd,bqkhd->bhqk', qr, k_nb).astype(jnp.float32) * ATTN_SCALE + bias.astype(jnp.float32)[None]
        s_cx = jnp.einsum('bqhd,bkhd->bhqk', qr, kc).astype(jnp.float32) * ATTN_SCALE
        p = jax.nn.softmax(jnp.concatenate([s_nb, s_cx], -1), -1).astype(v.dtype)
        return (jnp.einsum('bhqk,bqkhd->bqhd', p[..., :n_nb], v_nb)
                + jnp.einsum('bhqk,bkhd->bqhd', p[..., n_nb:], vc))

    out = lax.map(row_block, (jnp.arange(rows, dtype=jnp.int32), qg))
    return jnp.moveaxis(out, 0, 1).reshape(b, s, h, d)


def mixer_ab(a_lat, a_ctx, ctx_kv_only, w_in, w_out, lam_vecs, subln_g, qk_g, lam_init, cos, sin):
    b = a_lat.shape[0]

    def split_q(p):
        n = p.shape[1]
        q_d = p[..., :DIFF_QK].reshape(b, n, DIFF_HEADS, 2, HEAD_DIM)
        q_g = rms_norm(p[..., DIFF_QK:AB_Q].reshape(b, n, GQA_KV_HEADS, GQA_GROUP, HEAD_DIM), qk_g[0])
        return q_d, q_g

    def split_kv(p):
        n = p.shape[1]
        o1 = DIFF_QK
        o2 = o1 + DIFF_V
        o3 = o2 + GQA_KV_W
        k_d = p[..., :o1].reshape(b, n, DIFF_HEADS, 2, HEAD_DIM)
        v_d = p[..., o1:o2].reshape(b, n, DIFF_HEADS, 2 * HEAD_DIM)
        k_g = rms_norm(p[..., o2:o3].reshape(b, n, GQA_KV_HEADS, HEAD_DIM), qk_g[1])
        v_g = p[..., o3:].reshape(b, n, GQA_KV_HEADS, HEAD_DIM)
        return k_d, v_d, k_g, v_g

    lv = lam_vecs.astype(jnp.float32)
    lam = jnp.exp(jnp.sum(lv[0] * lv[1])) - jnp.exp(jnp.sum(lv[2] * lv[3])) + lam_init

    p_lat = a_lat @ w_in
    q_d, q_g = split_q(p_lat[..., :AB_Q])
    k_d, v_d, k_g, v_g = split_kv(p_lat[..., AB_Q:])
    q_d, k_d, q_g, k_g = (apply_rope(t, cos, sin) for t in (q_d, k_d, q_g, k_g))
    if ctx_kv_only:
        ck_d, cv_d, ck_g, cv_g = split_kv(a_ctx @ w_in[:, AB_Q:])
    else:
        p_ctx = a_ctx @ w_in
        cq_d, cq_g = split_q(p_ctx[..., :AB_Q])
        ck_d, cv_d, ck_g, cv_g = split_kv(p_ctx[..., AB_Q:])

    kd_all = jnp.concatenate([k_d, ck_d], 1)
    vd_all = jnp.concatenate([v_d, cv_d], 1)
    kg_all = jnp.concatenate([k_g, ck_g], 1)
    vg_all = jnp.concatenate([v_g, cv_g], 1)
    o_d = sweep_query_blocks(lambda _, qb: diff_attend(qb, kd_all, vd_all, lam), q_d)
    o_g = sweep_query_blocks(lambda _, qb: gqa_attend(qb, kg_all, vg_all), q_g)

    def merge(od, og):
        n = od.shape[1]
        od = rms_norm(od, subln_g) * (1.0 - lam_init)
        return jnp.concatenate([od.reshape(b, n, DIFF_V), og.reshape(b, n, GQA_Q)], -1) @ w_out

    out_lat = merge(o_d, o_g)
    if ctx_kv_only:
        return out_lat, None
    out_ctx = merge(diff_attend(cq_d, ck_d, cv_d, lam), gqa_attend(cq_g, ck_g, cv_g))
    return out_lat, out_ctx


def mixer_cd(a_lat, a_ctx, ctx_kv_only, w_in, w_out, sink, rpb, cos, sin):
    b = a_lat.shape[0]
    sink_hg = sink.reshape(WIN_KV_HEADS, WIN_GROUP)

    def split_q(p):
        n = p.shape[1]
        q_w = p[..., :WIN_Q].reshape(b, n, WIN_KV_HEADS, WIN_GROUP, HEAD_DIM)
        q_n = p[..., WIN_Q:CD_Q].reshape(b, n, NA_HEADS, HEAD_DIM)
        return q_w, q_n

    def split_kv(p):
        n = p.shape[1]
        o1 = WIN_KV_W
        o2 = o1 + WIN_KV_W
        o3 = o2 + NA_W
        k_w = p[..., :o1].reshape(b, n, WIN_KV_HEADS, HEAD_DIM)
        v_w = p[..., o1:o2].reshape(b, n, WIN_KV_HEADS, HEAD_DIM)
        k_n = p[..., o2:o3].reshape(b, n, NA_HEADS, HEAD_DIM)
        v_n = p[..., o3:].reshape(b, n, NA_HEADS, HEAD_DIM)
        return k_w, v_w, k_n, v_n

    p_lat = a_lat @ w_in
    q_w, q_n = split_q(p_lat[..., :CD_Q])
    k_w, v_w, k_n, v_n = split_kv(p_lat[..., CD_Q:])
    q_w = apply_rope(q_w, cos, sin)
    k_w = apply_rope(k_w, cos, sin)
    if ctx_kv_only:
        ck_w, cv_w, ck_n, cv_n = split_kv(a_ctx @ w_in[:, CD_Q:])
    else:
        p_ctx = a_ctx @ w_in
        cq_w, cq_n = split_q(p_ctx[..., :CD_Q])
        ck_w, cv_w, ck_n, cv_n = split_kv(p_ctx[..., CD_Q:])

    o_w = window_attention(q_w, k_w, v_w, ck_w, cv_w, sink_hg)
    o_n = neighbourhood_attention(q_n, k_n, v_n, ck_n, cv_n, rpb)

    def merge(ow, on):
        n = ow.shape[1]
        return jnp.concatenate([ow.reshape(b, n, WIN_Q), on.reshape(b, n, NA_W)], -1) @ w_out

    out_lat = merge(o_w, o_n)
    if ctx_kv_only:
        return out_lat, None
    n_ctx = a_ctx.shape[1]
    co_w = sink_attend(cq_w, ck_w, cv_w, sink_hg)
    co_n = gqa_attend(cq_n.reshape(b, n_ctx, NA_HEADS, 1, HEAD_DIM), ck_n, cv_n)
    return out_lat, merge(co_w, co_n)


def hier_moe(h, w_group, b_group, w_router, b_router, w1, w3, w2):
    t, d = h.shape
    g_logits = (h @ w_group).astype(jnp.float32) + b_group.astype(jnp.float32)
    _, g_idx = lax.top_k(g_logits, 1)
    g_w = jnp.take_along_axis(jax.nn.softmax(g_logits, -1), g_idx, -1)
    e_logits = ((h @ w_router).astype(jnp.float32) + b_router.astype(jnp.float32)).reshape(t, N_GROUPS, EXPERTS_PER_GROUP)
    e_in = jnp.take_along_axis(e_logits, g_idx[:, :, None], 1)[:, 0]
    top_v, top_i = lax.top_k(e_in, TOP_K_IN_GROUP)
    weights = g_w * jax.nn.softmax(top_v, -1)
    experts = g_idx * EXPERTS_PER_GROUP + top_i

    n_assign = t * TOP_K_IN_GROUP
    e_flat = experts.reshape(n_assign)
    tok = jnp.repeat(jnp.arange(t, dtype=jnp.int32), TOP_K_IN_GROUP)
    w_flat = weights.reshape(n_assign)
    order = jnp.argsort(e_flat)
    e_s = e_flat[order]
    tok_s = tok[order]
    w_s = w_flat[order]
    counts = jnp.bincount(e_flat, length=N_EXPERTS)
    starts = jnp.cumsum(counts) - counts
    padded = (counts + MOE_BLOCK - 1) // MOE_BLOCK * MOE_BLOCK
    p_ends = jnp.cumsum(padded)
    p_starts = p_ends - padded
    dest = p_starts[e_s] + (jnp.arange(n_assign, dtype=jnp.int32) - starts[e_s])
    n_blocks = (n_assign + MOE_BLOCK - 1) // MOE_BLOCK + N_EXPERTS
    buf = jnp.zeros((n_blocks * MOE_BLOCK, d), h.dtype).at[dest].set(h[tok_s])
    blk_e = jnp.minimum(jnp.searchsorted(p_ends, jnp.arange(n_blocks) * MOE_BLOCK, side='right'), N_EXPERTS - 1)

    def expert_block(a):
        xb, e = a
        return (jax.nn.silu(xb @ w1[e]) * (xb @ w3[e])) @ w2[e]

    yb = lax.map(expert_block, (buf.reshape(n_blocks, MOE_BLOCK, d), blk_e)).reshape(n_blocks * MOE_BLOCK, d)
    return jnp.zeros((t, d), h.dtype).at[tok_s].add(w_s[:, None].astype(h.dtype) * yb[dest])


def setup_inputs(seed: int = 0) -> dict:
    key = jax.random.key(seed)
    ks = jax.random.split(key, 32)
    D = D_MODEL

    def nrm(k, shape, s):
        return jax.random.normal(k, shape, jnp.float32) * s

    ab_kv_scale = jnp.concatenate([jnp.ones((DIFF_QK,)), jnp.full((DIFF_V,), BETA), jnp.ones((GQA_KV_W,)), jnp.full((GQA_KV_W,), BETA)]).astype(jnp.float32)
    cd_kv_scale = jnp.concatenate([jnp.ones((WIN_KV_W,)), jnp.full((WIN_KV_W,), BETA), jnp.ones((NA_W,)), jnp.full((NA_W,), BETA)]).astype(jnp.float32)
    return {
        'x': nrm(ks[0], (BATCH, SEQ, D), 1.0),
        'c': nrm(ks[1], (BATCH, D), 1.0),
        'ctx': nrm(ks[2], (BATCH, CTX_LEN, D), 1.0),
        'c_ctx': nrm(ks[3], (D,), 1.0),
        'mod_w': nrm(ks[4], (DEPTH, D, 6 * D), 0.5 * D ** -0.5),
        'mod_b': nrm(ks[5], (DEPTH, 6 * D), 0.02),
        'ln_g': 1.0 + nrm(ks[6], (DEPTH, 2, D), 0.02),
        'ln_b': nrm(ks[7], (DEPTH, 2, D), 0.02),
        'ab_w_in': jnp.concatenate([nrm(ks[8], (N_EVEN, D, AB_Q), D ** -0.5), nrm(ks[9], (N_EVEN, D, AB_KV), D ** -0.5) * ab_kv_scale], -1),
        'ab_w_out': nrm(ks[10], (N_EVEN, AB_OUT, D), AB_OUT ** -0.5 * BETA),
        'diff_lambda': nrm(ks[11], (N_EVEN, 4, HEAD_DIM), 0.1),
        'diff_subln_g': 1.0 + nrm(ks[12], (N_EVEN, 2 * HEAD_DIM), 0.02),
        'gqa_qk_g': 1.0 + nrm(ks[13], (N_EVEN, 2, HEAD_DIM), 0.02),
        'cd_w_in': jnp.concatenate([nrm(ks[14], (N_ODD, D, CD_Q), D ** -0.5), nrm(ks[15], (N_ODD, D, CD_KV), D ** -0.5) * cd_kv_scale], -1),
        'cd_w_out': nrm(ks[16], (N_ODD, CD_OUT, D), CD_OUT ** -0.5 * BETA),
        'win_sink': nrm(ks[17], (N_ODD, WIN_HEADS), 0.5),
        'na_rpb': nrm(ks[18], (N_ODD, NA_HEADS, 2 * NA_ROWS_MAX - 1, 2 * NA_COLS - 1), 0.1),
        'moe_w_group': nrm(ks[19], (DEPTH, D, N_GROUPS), D ** -0.5),
        'moe_b_group': nrm(ks[20], (DEPTH, N_GROUPS), 0.01),
        'moe_w_router': nrm(ks[21], (DEPTH, D, N_EXPERTS), D ** -0.5),
        'moe_b_router': nrm(ks[22], (DEPTH, N_EXPERTS), 0.01),
        'moe_w1': nrm(ks[23], (DEPTH, N_EXPERTS, D, D_EXPERT), D ** -0.5),
        'moe_w3': nrm(ks[24], (DEPTH, N_EXPERTS, D, D_EXPERT), D ** -0.5),
        'moe_w2': nrm(ks[25], (DEPTH, N_EXPERTS, D_EXPERT, D), D_EXPERT ** -0.5 * BETA),
    }


def reference(x, c, ctx, c_ctx, mod_w, mod_b, ln_g, ln_b, ab_w_in, ab_w_out, diff_lambda, diff_subln_g, gqa_qk_g, cd_w_in, cd_w_out, win_sink, na_rpb, moe_w_group, moe_b_group, moe_w_router, moe_b_router, moe_w1, moe_w3, moe_w2):
    b, s, d = x.shape
    n_ctx = ctx.shape[1]
    cos, sin = axial_rope_tables(s)
    silu_c = jax.nn.silu(c)
    silu_cc = jax.nn.silu(c_ctx)
    h_lat, h_ctx = x, ctx
    for i in range(DEPTH):
        last = i == DEPTH - 1
        j = i // 2
        mods = (silu_c @ mod_w[i] + mod_b[i]).reshape(b, 1, 6, d)
        n_cm = 2 if last else 6
        cmods = (silu_cc @ mod_w[i][:, :n_cm * d] + mod_b[i][:n_cm * d]).reshape(1, 1, n_cm, d)

        a_lat = modulate(h_lat, mods[:, :, 0], mods[:, :, 1])
        a_ctx = modulate(h_ctx, cmods[:, :, 0], cmods[:, :, 1])
        if i % 2 == 0:
            o_lat, o_ctx = mixer_ab(a_lat, a_ctx, last, ab_w_in[j], ab_w_out[j], diff_lambda[j], diff_subln_g[j], gqa_qk_g[j], lambda_init(i), cos, sin)
        else:
            o_lat, o_ctx = mixer_cd(a_lat, a_ctx, last, cd_w_in[j], cd_w_out[j], win_sink[j], na_rpb[j], cos, sin)
        h_lat = layer_norm(ALPHA * h_lat + mods[:, :, 2] * o_lat, ln_g[i, 0], ln_b[i, 0])

        def moe(tokens):
            return hier_moe(tokens, moe_w_group[i], moe_b_group[i], moe_w_router[i], moe_b_router[i], moe_w1[i], moe_w3[i], moe_w2[i])

        f_lat = modulate(h_lat, mods[:, :, 3], mods[:, :, 4]).reshape(b * s, d)
        if last:
            y_lat = moe(f_lat)
        else:
            h_ctx = layer_norm(ALPHA * h_ctx + cmods[:, :, 2] * o_ctx, ln_g[i, 0], ln_b[i, 0])
            f_ctx = modulate(h_ctx, cmods[:, :, 3], cmods[:, :, 4]).reshape(b * n_ctx, d)
            y = moe(jnp.concatenate([f_lat, f_ctx], 0))
            y_lat = y[:b * s]
            h_ctx = layer_norm(ALPHA * h_ctx + cmods[:, :, 5] * y[b * s:].reshape(b, n_ctx, d), ln_g[i, 1], ln_b[i, 1])
        h_lat = layer_norm(ALPHA * h_lat + mods[:, :, 5] * y_lat.reshape(b, s, d), ln_g[i, 1], ln_b[i, 1])
    return h_lat
```

```cpp
#include <hip/hip_runtime.h>
#include <stdint.h>
#include <stdio.h>

#ifndef MK_SINGLE
#define MK_SINGLE 0
#endif

typedef unsigned short bf16_t;
typedef short bf16x8 __attribute__((ext_vector_type(8)));
typedef short s16x4 __attribute__((ext_vector_type(4)));
typedef short v4i16_t __attribute__((ext_vector_type(4)));
typedef float f32x16 __attribute__((ext_vector_type(16)));
typedef float f32x4 __attribute__((ext_vector_type(4)));
typedef float f32x2 __attribute__((ext_vector_type(2)));
typedef __bf16 bf16x2_t __attribute__((ext_vector_type(2)));
typedef unsigned u32x4 __attribute__((ext_vector_type(4)));
typedef unsigned u32x2 __attribute__((ext_vector_type(2)));
#define LAS __attribute__((address_space(3)))

constexpr int D = 1024, NB = 2, SEQ = 8192, NCTX = 256, SP = SEQ + NCTX  , R = NB * SP  ;
constexpr int NQKV = 2304, NTHR = 512, CAP = R;
constexpr float ALPHA = 1.4142135623730951f;
constexpr float LOG2E = 1.4426950408889634f;
constexpr float C2 = 0.125f * LOG2E;
constexpr float NEGBIG = -1e30f;

constexpr size_t MiB = 1u << 20;
constexpr size_t WS_CTL = 0, CTL_BYTES = 1 * MiB;
constexpr size_t WS_MODS = 1 * MiB;
constexpr size_t WS_ROPE = 2 * MiB;
constexpr size_t WS_WIN = 4 * MiB;
constexpr size_t WS_WOUT = 13 * MiB;
constexpr size_t WS_W1 = 18 * MiB;
constexpr size_t WS_W3 = 82 * MiB;
constexpr size_t WS_W2 = 146 * MiB;
constexpr size_t WS_ACT = 210 * MiB;
constexpr size_t WS_H = 243 * MiB;
constexpr size_t WS_QKV = 309 * MiB;
constexpr size_t WS_AO = 384 * MiB;
constexpr size_t WS_TOK = 417 * MiB;
constexpr size_t WS_PERM = 418 * MiB;
constexpr size_t WS_HB = 309 * MiB;
constexpr size_t WS_YB = 343 * MiB;
constexpr size_t WS_END = 421 * MiB;
constexpr int CW_BAR = 4096, CW_CNT = 16384;

constexpr int LDS_BYTES = 155648;

__device__ __forceinline__ unsigned cvtpk(float lo, float hi) { f32x2 v = {lo, hi}; bf16x2_t b = __builtin_convertvector(v, bf16x2_t); return __builtin_bit_cast(unsigned, b); }
__device__ __forceinline__ bf16_t f2bf(float f) { unsigned u = __builtin_bit_cast(unsigned, f); return (bf16_t)((u + 0x7fffu + ((u >> 16) & 1u)) >> 16); }
__device__ __forceinline__ float bf2f(unsigned short h) { return __builtin_bit_cast(float, (unsigned)h << 16); }
__device__ __forceinline__ int crow(int r, int hi) { return (r & 3) + 8 * (r >> 2) + 4 * hi; }
__device__ __forceinline__ float wave_sum(float v) {
#pragma unroll
    for (int o = 1; o < 64; o <<= 1) v += __shfl_xor(v, o);
    return v;
}
__device__ __forceinline__ float swap_add(float v) { auto rr = __builtin_amdgcn_permlane32_swap(__float_as_uint(v), __float_as_uint(v), false, false); return __uint_as_float(rr[0]) + __uint_as_float(rr[1]); }
__device__ __forceinline__ float swap_max(float v) { auto rr = __builtin_amdgcn_permlane32_swap(__float_as_uint(v), __float_as_uint(v), false, false); return fmaxf(__uint_as_float(rr[0]), __uint_as_float(rr[1])); }
__device__ __forceinline__ f32x16 mfma32(bf16x8 a, bf16x8 b, f32x16 c) { return __builtin_amdgcn_mfma_f32_32x32x16_bf16(a, b, c, 0, 0, 0); }
__device__ __forceinline__ float silu_f(float x) { return x / (1.f + __expf(-x)); }

#define XB_TMO      128
#define XB_XCNT(j)  (256  + 64 * (j))
#define XB_XSUB(j)  (1280 + 64 * (j))
#define XB_XGEN(j)  (2304 + 64 * (j))
#define XB_TOP      3328
#define XB_TOPGEN   3392
#define XCD_BAR_WORDS 3456
#define XB_SPIN_CAP (1u << 20)
__device__ __forceinline__ unsigned xb_ld(unsigned* p)              { return __hip_atomic_load(p, __ATOMIC_RELAXED, __HIP_MEMORY_SCOPE_AGENT); }
__device__ __forceinline__ unsigned xb_add(unsigned* p, unsigned v) { return __hip_atomic_fetch_add(p, v, __ATOMIC_RELAXED, __HIP_MEMORY_SCOPE_AGENT); }
__device__ __forceinline__ unsigned xb_xcc_id() { return (unsigned)__builtin_amdgcn_s_getreg((3 << 11) | 20) & 0xFu; }
#define XB_SPIN(cond, bar) do { unsigned _sp = 0; while (cond) { __builtin_amdgcn_s_sleep(1); \
    if ((++_sp & 255u) == 0u) { if (xb_ld(&(bar)[XB_TMO])) break; if (_sp > XB_SPIN_CAP) { atomicAdd(&(bar)[XB_TMO], 1u); break; } } } } while (0)
struct XcdBarrier { unsigned* bar; unsigned x; volatile LAS unsigned* st; };
__device__ __forceinline__ XcdBarrier xcd_barrier_post(unsigned* bar, volatile LAS unsigned* st) {
    XcdBarrier b; b.bar = bar; b.x = xb_xcc_id(); b.st = st;
    if (threadIdx.x == 0) (void)xb_add(&bar[XB_XCNT(b.x)], 1u);
    return b;
}
__device__ __forceinline__ void xcd_barrier_complete(unsigned* bar, unsigned x, unsigned& nloc, unsigned& nx) {
    const unsigned G = gridDim.x * gridDim.y * gridDim.z;
    unsigned sum, cnt, mine, sp = 0u;
    for (;;) {
        sum = 0u; cnt = 0u; mine = 0u;
#pragma unroll
        for (unsigned j = 0; j < 16; ++j) { const unsigned c = xb_ld(&bar[XB_XCNT(j)]); sum += c; cnt += (c > 0u) ? 1u : 0u; mine = (j == x) ? c : mine; }
        if (sum == G) break;
        __builtin_amdgcn_s_sleep(1);
        if ((++sp & 255u) == 0u) { if (xb_ld(&bar[XB_TMO])) break; if (sp > XB_SPIN_CAP) { atomicAdd(&bar[XB_TMO], 1u); break; } }
    }
    nloc = mine > 0u ? mine : 1u; nx = cnt > 0u ? cnt : 1u;
}
__device__ __forceinline__ void xcd_barrier(const XcdBarrier& b) {
    asm volatile("s_waitcnt vmcnt(0)" ::: "memory");
    __syncthreads();
    if (threadIdx.x == 0) {
        unsigned* bar = b.bar;
        __builtin_amdgcn_s_waitcnt(0);
        unsigned nloc = b.st[0], nx = b.st[1];
        if (nloc == 0u) { xcd_barrier_complete(bar, b.x, nloc, nx); b.st[0] = nloc; b.st[1] = nx; }
        const unsigned old = xb_add(&bar[XB_XSUB(b.x)], 1u);
        const unsigned gen = old / nloc;
        if (old + 1u == (gen + 1u) * nloc) {
            __builtin_amdgcn_fence(__ATOMIC_RELEASE, "agent");
            asm volatile("s_waitcnt vmcnt(0)" ::: "memory");
            const unsigned og = xb_add(&bar[XB_TOP], 1u);
            const unsigned tg = og / nx;
            if (og + 1u == (tg + 1u) * nx) xb_add(&bar[XB_TOPGEN], 1u);
            else XB_SPIN(xb_ld(&bar[XB_TOPGEN]) == tg, bar);
            __builtin_amdgcn_fence(__ATOMIC_ACQUIRE, "agent");
            xb_add(&bar[XB_XGEN(b.x)], 1u);
            asm volatile("s_waitcnt vmcnt(0)" ::: "memory");
        } else {
            XB_SPIN(xb_ld(&bar[XB_XGEN(b.x)]) == gen, bar);
            __builtin_amdgcn_fence(__ATOMIC_ACQUIRE, "agent");
            asm volatile("s_waitcnt vmcnt(0)" ::: "memory");
        }
    }
    __syncthreads();
}

struct Args { const float* in[24]; float* out; unsigned char* ws; int ph_lo, ph_hi; };
struct Ctx {
    char* lds; int tid, lane, wid, bid, nblk;
    const float* const* in; float* out; unsigned char* ws;
};
#define WSP(T, off) ((T*)(C.ws + (off)))

__device__ __forceinline__ const float* hin_row(const Ctx& C, int row) {
    const int b = row / SP, t = row - b * SP;
    return t < SEQ ? C.in[0] + ((size_t)b * SEQ + t) * D : C.in[2] + ((size_t)b * NCTX + (t - SEQ)) * D;
}
__device__ __forceinline__ int row_set(int row) { const int b = row / SP, t = row - b * SP; return t < SEQ ? b : 2; }

__device__ void conv_tile(const float* src, int K, int N, bf16_t* dst, int k0, int n0, char* lds, int tid) {
    bf16_t (*tl)[72] = (bf16_t (*)[72])lds;
    const int r = tid >> 4, c4 = tid & 15;
#pragma unroll
    for (int h = 0; h < 2; ++h) {
        const int k = r + 32 * h;
        const f32x4 v = *(const f32x4*)(src + (size_t)(k0 + k) * N + n0 + c4 * 4);
        tl[c4 * 4 + 0][k] = f2bf(v[0]); tl[c4 * 4 + 1][k] = f2bf(v[1]); tl[c4 * 4 + 2][k] = f2bf(v[2]); tl[c4 * 4 + 3][k] = f2bf(v[3]);
    }
    __syncthreads();
    const int n = tid >> 3, c = tid & 7;
    const u32x4 o = *(const u32x4*)&tl[n][c * 8];
    *(u32x4*)(dst + (size_t)(n0 + n) * K + k0 + c * 8) = o;
    __syncthreads();
}

__device__ void phase_prologue(const Ctx& C) {
    const int tid = C.tid;
    {
        float* sv = (float*)C.lds;
        float* red = (float*)(C.lds + 12288);
        for (int i = tid; i < 3072; i += NTHR) { const int set = i >> 10, k = i & 1023; const float v = set < 2 ? C.in[1][set * D + k] : C.in[3][k]; sv[i] = silu_f(v); }
        __syncthreads();
        float* mods = WSP(float, WS_MODS);
        for (int item = C.bid; item < 256; item += C.nblk) {
            const int layer = item >> 7, col0 = (item & 127) * 48;
            if (tid < 384) {
                const int cg = tid % 12, ks = tid / 12;
                f32x4 a0 = {0, 0, 0, 0}, a1 = a0, a2 = a0;
                const float* W = C.in[4] + (size_t)layer * D * 6144 + col0 + cg * 4;
                for (int kk = 0; kk < 32; ++kk) {
                    const int k = ks * 32 + kk;
                    const f32x4 w = *(const f32x4*)(W + (size_t)k * 6144);
                    a0 += sv[k] * w; a1 += sv[1024 + k] * w; a2 += sv[2048 + k] * w;
                }
                float* rp = red + (ks * 12 + cg) * 12;
                *(f32x4*)(rp) = a0; *(f32x4*)(rp + 4) = a1; *(f32x4*)(rp + 8) = a2;
            }
            __syncthreads();
            if (tid < 144) {
                const int cg = tid / 12, v = tid % 12;
                float s = 0.f;
                for (int ks = 0; ks < 32; ++ks) s += red[(ks * 12 + cg) * 12 + v];
                const int set = v >> 2, col = col0 + cg * 4 + (v & 3);
                mods[(layer * 3 + set) * 6144 + col] = s + C.in[5][layer * 6144 + col];
            }
            __syncthreads();
        }
    }
    {
        float* cs = WSP(float, WS_ROPE); float* sn = cs + SEQ * 32;
        for (int idx = C.bid * NTHR + tid; idx < SEQ * 32; idx += C.nblk * NTHR) {
            const int t = idx >> 5, j = idx & 31;
            const float pos = (float)(j < 16 ? (t >> 6) : (t & 63));
            const float inv = powf(10000.f, -(float)(j & 15) / 16.f);
            const float ang = pos * inv;
            float s, c; sincosf(ang, &s, &c);
            cs[idx] = c; sn[idx] = s;
        }
    }
    {
        constexpr int T_WIN = 576, T_WOUT = 256, T_EXP = 8192;
        constexpr int TOT = 2 * T_WIN + 2 * T_WOUT + 3 * T_EXP;
        for (int tile = C.bid; tile < TOT; tile += C.nblk) {
            int t = tile; const float* src; bf16_t* dst; int K, N, ti;
            if (t < 2 * T_WIN) { const int l = t / T_WIN; ti = t % T_WIN; src = C.in[l ? 13 : 8]; dst = WSP(bf16_t, WS_WIN) + (size_t)l * NQKV * D; K = D; N = NQKV; }
            else if ((t -= 2 * T_WIN) < 2 * T_WOUT) { const int l = t / T_WOUT; ti = t % T_WOUT; src = C.in[l ? 14 : 9]; dst = WSP(bf16_t, WS_WOUT) + (size_t)l * D * D; K = D; N = D; }
            else if ((t -= 2 * T_WOUT) < T_EXP) { const int m = t >> 7; ti = t & 127; src = C.in[21] + (size_t)m * 524288; dst = WSP(bf16_t, WS_W1) + (size_t)m * 524288; K = 1024; N = 512; }
            else if ((t -= T_EXP) < T_EXP) { const int m = t >> 7; ti = t & 127; src = C.in[22] + (size_t)m * 524288; dst = WSP(bf16_t, WS_W3) + (size_t)m * 524288; K = 1024; N = 512; }
            else { t -= T_EXP; const int m = t >> 7; ti = t & 127; src = C.in[23] + (size_t)m * 524288; dst = WSP(bf16_t, WS_W2) + (size_t)m * 524288; K = 512; N = 1024; }
            const int nn = N >> 6; const int kt = ti / nn, nt = ti % nn;
            conv_tile(src, K, N, dst, kt * 64, nt * 64, C.lds, tid);
        }
    }
}

__device__ void phase_mod0(const Ctx& C) {
    const float* mods = WSP(float, WS_MODS);
    bf16_t* act = WSP(bf16_t, WS_ACT);
    for (int row = C.bid * 8 + C.wid; row < R; row += C.nblk * 8) {
        const float* src = hin_row(C, row); const float* m = mods + row_set(row) * 6144;
#pragma unroll
        for (int i = 0; i < 4; ++i) {
            const int col = C.lane * 4 + 256 * i;
            const f32x4 v = *(const f32x4*)(src + col), sh = *(const f32x4*)(m + col), sc = *(const f32x4*)(m + 1024 + col);
            const f32x4 a = v * (1.f + sc) + sh;
            u32x2 o; o.x = cvtpk(a[0], a[1]); o.y = cvtpk(a[2], a[3]);
            *(u32x2*)(act + (size_t)row * D + col) = o;
        }
    }
}

constexpr int GSTAGE = 384 * 128;
template <int KT>
__device__ __forceinline__ void gemm_core(char* lds, const bf16_t* const (&rp)[6], f32x16 (&acc)[2][2], int tid) {
    const int lane = tid & 63, wid = tid >> 6, r32 = lane & 31, hi = lane >> 5;
    const int wn = wid >> 2, wt = wid & 3;
    const int c = tid & 7, r0 = tid >> 3;
    int woff[6];
#pragma unroll
    for (int i = 0; i < 6; ++i) { const int row = r0 + 64 * i; woff[i] = row * 128 + ((c ^ ((row >> 1) & 7)) << 4); }
    const int sw = (r32 >> 1) & 7;
    const int arow = (wn * 64 + r32) * 128, brow = (128 + wt * 64 + r32) * 128;
#pragma unroll
    for (int mi = 0; mi < 2; ++mi)
#pragma unroll
        for (int ti = 0; ti < 2; ++ti)
#pragma unroll
            for (int r = 0; r < 16; ++r) acc[mi][ti][r] = 0.f;
    u32x4 st[6];
#pragma unroll
    for (int i = 0; i < 6; ++i) st[i] = *(const u32x4*)(rp[i]);
#pragma unroll
    for (int i = 0; i < 6; ++i) *(u32x4*)(lds + woff[i]) = st[i];
    __syncthreads();
    for (int kt = 0; kt < KT; ++kt) {
        const char* cur = lds + (kt & 1) * GSTAGE;
        char* nxt = lds + ((kt + 1) & 1) * GSTAGE;
        if (kt + 1 < KT) {
#pragma unroll
            for (int i = 0; i < 6; ++i) st[i] = *(const u32x4*)(rp[i] + (kt + 1) * 64);
        }
#pragma unroll
        for (int ks = 0; ks < 4; ++ks) {
            const int co = ((2 * ks + hi) ^ sw) << 4;
            const bf16x8 a0 = *(const bf16x8*)(cur + arow + co), a1 = *(const bf16x8*)(cur + arow + 32 * 128 + co);
            const bf16x8 b0 = *(const bf16x8*)(cur + brow + co), b1 = *(const bf16x8*)(cur + brow + 32 * 128 + co);
            acc[0][0] = mfma32(a0, b0, acc[0][0]); acc[0][1] = mfma32(a0, b1, acc[0][1]);
            acc[1][0] = mfma32(a1, b0, acc[1][0]); acc[1][1] = mfma32(a1, b1, acc[1][1]);
        }
        if (kt + 1 < KT) {
#pragma unroll
            for (int i = 0; i < 6; ++i) *(u32x4*)(nxt + woff[i]) = st[i];
        }
        __syncthreads();
    }
}

__device__ void phase_proj(const Ctx& C, int layer) {
    const int tid = C.tid, lane = C.lane, wid = C.wid, r32 = lane & 31, hi = lane >> 5, wn = wid >> 2, wt = wid & 3;
    const bf16_t* Wt = WSP(bf16_t, WS_WIN) + (size_t)layer * NQKV * D;
    const bf16_t* act = WSP(bf16_t, WS_ACT);
    bf16_t* qkv = WSP(bf16_t, WS_QKV);
    const float* cs = WSP(float, WS_ROPE); const float* sn = cs + SEQ * 32;
    const int c = tid & 7, r0 = tid >> 3;
    constexpr int NTT = R / 256, NNT = NQKV / 128;
    for (int w = C.bid; w < NTT * NNT; w += C.nblk) {
        const int nt = w % NNT, tt = w / NNT;
        const bf16_t* rp[6];
        rp[0] = Wt + (size_t)(nt * 128 + r0) * D + c * 8; rp[1] = rp[0] + (size_t)64 * D;
#pragma unroll
        for (int i = 0; i < 4; ++i) rp[2 + i] = act + (size_t)(tt * 256 + r0 + 64 * i) * D + c * 8;
        f32x16 acc[2][2];
        gemm_core<16>(C.lds, rp, acc, tid);
        const int seg = (nt * 128 + wn * 64) >> 6;
        bool rms, rope; const float* g = nullptr;
        if (layer == 0) { rms = (seg >= 8 && seg < 16) || seg == 32 || seg == 33; rope = seg < 24 || seg == 32 || seg == 33; g = C.in[12] + (seg < 16 ? 0 : 64); }
        else { rms = false; rope = seg < 8 || seg == 16 || seg == 17; }
        const float qs = seg < 16 ? C2 : 1.f;
#pragma unroll
        for (int ti = 0; ti < 2; ++ti) {
            const int tok = tt * 256 + wt * 64 + ti * 32 + r32; const int b = tok / SP, t = tok - b * SP;
            f32x16 x1 = acc[0][ti], x2 = acc[1][ti];
            if (rms) {
                float ss = 0.f;
#pragma unroll
                for (int r = 0; r < 16; ++r) ss += x1[r] * x1[r] + x2[r] * x2[r];
                ss = swap_add(ss);
                const float rinv = rsqrtf(ss * (1.f / 64.f) + 1e-6f);
#pragma unroll
                for (int g4 = 0; g4 < 4; ++g4) {
                    const f32x4 g1 = *(const f32x4*)(g + 8 * g4 + 4 * hi), g2 = *(const f32x4*)(g + 32 + 8 * g4 + 4 * hi);
#pragma unroll
                    for (int i = 0; i < 4; ++i) { x1[4 * g4 + i] *= rinv * g1[i]; x2[4 * g4 + i] *= rinv * g2[i]; }
                }
            }
            if (rope && t < SEQ) {
#pragma unroll
                for (int g4 = 0; g4 < 4; ++g4) {
                    const f32x4 cc = *(const f32x4*)(cs + t * 32 + 8 * g4 + 4 * hi), ssn = *(const f32x4*)(sn + t * 32 + 8 * g4 + 4 * hi);
#pragma unroll
                    for (int i = 0; i < 4; ++i) { const float a = x1[4 * g4 + i], bb = x2[4 * g4 + i]; x1[4 * g4 + i] = a * cc[i] - bb * ssn[i]; x2[4 * g4 + i] = bb * cc[i] + a * ssn[i]; }
                }
            }
            bf16_t* orow = qkv + (size_t)tok * NQKV + seg * 64;
#pragma unroll
            for (int g4 = 0; g4 < 4; ++g4) {
                u32x2 o1, o2;
                o1.x = cvtpk(x1[4 * g4] * qs, x1[4 * g4 + 1] * qs); o1.y = cvtpk(x1[4 * g4 + 2] * qs, x1[4 * g4 + 3] * qs);
                o2.x = cvtpk(x2[4 * g4] * qs, x2[4 * g4 + 1] * qs); o2.y = cvtpk(x2[4 * g4 + 2] * qs, x2[4 * g4 + 3] * qs);
                *(u32x2*)(orow + 8 * g4 + 4 * hi) = o1; *(u32x2*)(orow + 32 + 8 * g4 + 4 * hi) = o2;
            }
        }
    }
}

constexpr int A_K = 0, A_V = 16384, A_RPB = 32768;
struct AttnP { int b, qcol, kcol, vcol, q0, kstart, nt; bf16_t* outp; int opitch, ocol; float sinkl2; int head; };
template <int MODE>
__device__ void attn_unit(const Ctx& C, const AttnP& P) {
    const int tid = C.tid, lane = C.lane, wid = C.wid, r32 = lane & 31, hi = lane >> 5;
    char* lds = C.lds;
    const bf16_t* qkv = WSP(bf16_t, WS_QKV) + (size_t)P.b * SP * NQKV;
    const int qw0 = P.q0 + wid * 32;
    const int qpos = qw0 + r32;
    int NT, lo = 0, R0 = 0;
    if (MODE == 0) NT = P.nt;
    else if (MODE == 1) { lo = P.q0 - 128 < 0 ? 0 : P.q0 - 128; const int hi_ = P.q0 + 384 > SEQ ? SEQ : P.q0 + 384; NT = 4 + (hi_ - lo) / 64; }
    else { const int gr = P.q0 >> 6; R0 = gr - 4 < 0 ? 0 : (gr - 4 > 120 ? 120 : gr - 4); int R1 = gr + 3 - 4; R1 = (R1 < 0 ? 0 : (R1 > 120 ? 120 : R1)) + 8; NT = 4 + (R1 - R0); }
#define krow_of(j) (MODE == 0 ? P.kstart + 64 * (j) : ((j) < 4 ? SEQ + 64 * (j) : (MODE == 1 ? lo + 64 * ((j) - 4) : (R0 + (j) - 4) * 64)))
    const int rq = qw0 >> 6, cq = qpos & 63;
    const int r0q = rq - 4 < 0 ? 0 : (rq - 4 > 120 ? 120 : rq - 4);
    const int csq = cq - 8 < 0 ? 0 : (cq - 8 > 48 ? 48 : cq - 8);
    const float* rpbL = (const float*)(lds + A_RPB);
    const int skey = tid >> 3, sc = tid & 7;
    const int kwoff = skey * 128 + ((sc ^ ((skey >> 1) & 7)) << 4);
    const int vwoff = (sc >> 2) * 4096 + skey * 64 + (sc & 3) * 16;
    const bf16_t* kg = qkv + (size_t)skey * NQKV + P.kcol + sc * 8;
    const bf16_t* vg = qkv + (size_t)skey * NQKV + P.vcol + sc * 8;
    bf16x8 qr[4];
    {
        const bf16_t* qp = qkv + (size_t)qpos * NQKV + P.qcol + hi * 8;
#pragma unroll
        for (int d0 = 0; d0 < 4; ++d0) qr[d0] = *(const bf16x8*)(qp + d0 * 16);
    }
    f32x16 o[2];
#pragma unroll
    for (int r = 0; r < 16; ++r) { o[0][r] = 0.f; o[1][r] = 0.f; }
    float m = NEGBIG, l = 0.f;
    const int sw = (r32 >> 1) & 7;
    const int vro = ((lane >> 4) & 1) * 32 + (lane & 3) * 8 + (4 * hi + ((lane & 15) >> 2)) * 64;
    u32x4 sk, sv;
    { const int kr = krow_of(0); sk = *(const u32x4*)(kg + (size_t)kr * NQKV); sv = *(const u32x4*)(vg + (size_t)kr * NQKV); }
    __syncthreads();
    *(u32x4*)(lds + A_K + kwoff) = sk; *(u32x4*)(lds + A_V + vwoff) = sv;
    __syncthreads();
    for (int j = 0; j < NT; ++j) {
        const int krow = krow_of(j);
        if (j + 1 < NT) { const int kr = krow_of(j + 1); sk = *(const u32x4*)(kg + (size_t)kr * NQKV); sv = *(const u32x4*)(vg + (size_t)kr * NQKV); }
        bool act = true;
        if (MODE == 1 && j >= 4) act = !(krow + 63 < qw0 - 128 || krow > qw0 + 31 + 128);
        if (MODE == 2 && j >= 4) { const int kr = krow >> 6; act = kr >= r0q && kr < r0q + 8; }
        if (act) {
            const char* Kb = lds + A_K + (j & 1) * 8192;
            f32x16 p0, p1;
#pragma unroll
            for (int r = 0; r < 16; ++r) { p0[r] = 0.f; p1[r] = 0.f; }
#pragma unroll
            for (int d0 = 0; d0 < 4; ++d0) {
                const int co = ((2 * d0 + hi) ^ sw) << 4;
                const bf16x8 a0 = *(const bf16x8*)(Kb + r32 * 128 + co), a1 = *(const bf16x8*)(Kb + (32 + r32) * 128 + co);
                p0 = mfma32(a0, qr[d0], p0); p1 = mfma32(a1, qr[d0], p1);
            }
            if (MODE == 1 && j >= 4) {
#pragma unroll
                for (int r = 0; r < 16; ++r) {
                    const int k0 = krow + crow(r, hi), d0_ = qpos - k0, d1_ = d0_ - 32;
                    if (d0_ > 128 || d0_ < -128) p0[r] = NEGBIG;
                    if (d1_ > 128 || d1_ < -128) p1[r] = NEGBIG;
                }
            }
            if (MODE == 2 && j >= 4) {
                const int kr = krow >> 6;
                const float* bp = rpbL + (kr - rq + 7) * 31 + 15 - cq;
#pragma unroll
                for (int r = 0; r < 16; ++r) {
                    const int kc0 = crow(r, hi), kc1 = kc0 + 32;
                    if (kc0 >= csq && kc0 < csq + 16) p0[r] += bp[kc0]; else p0[r] = NEGBIG;
                    if (kc1 >= csq && kc1 < csq + 16) p1[r] += bp[kc1]; else p1[r] = NEGBIG;
                }
            }
            float mx = fmaxf(p0[0], p1[0]);
#pragma unroll
            for (int r = 1; r < 16; ++r) mx = fmaxf(mx, fmaxf(p0[r], p1[r]));
            mx = swap_max(mx);
            if (__any(mx > m)) {
                const float mn = fmaxf(m, mx), alpha = __builtin_amdgcn_exp2f(m - mn);
                l *= alpha; m = mn;
#pragma unroll
                for (int r = 0; r < 16; ++r) { o[0][r] *= alpha; o[1][r] *= alpha; }
            }
            float ls = 0.f;
#pragma unroll
            for (int r = 0; r < 16; ++r) { p0[r] = __builtin_amdgcn_exp2f(p0[r] - m); p1[r] = __builtin_amdgcn_exp2f(p1[r] - m); ls += p0[r] + p1[r]; }
            l += ls;
            u32x4 pw[4];
#pragma unroll
            for (int s = 0; s < 2; ++s) {
                pw[s] = (u32x4){cvtpk(p0[8 * s], p0[8 * s + 1]), cvtpk(p0[8 * s + 2], p0[8 * s + 3]), cvtpk(p0[8 * s + 4], p0[8 * s + 5]), cvtpk(p0[8 * s + 6], p0[8 * s + 7])};
                pw[2 + s] = (u32x4){cvtpk(p1[8 * s], p1[8 * s + 1]), cvtpk(p1[8 * s + 2], p1[8 * s + 3]), cvtpk(p1[8 * s + 4], p1[8 * s + 5]), cvtpk(p1[8 * s + 6], p1[8 * s + 7])};
            }
            const LAS char* Vb = (const LAS char*)(lds + A_V + (j & 1) * 8192 + vro);
#pragma unroll
            for (int dh = 0; dh < 2; ++dh)
#pragma unroll
                for (int ks = 0; ks < 4; ++ks) {
                    const s16x4 vl = __builtin_bit_cast(s16x4, __builtin_amdgcn_ds_read_tr16_b64_v4i16((LAS v4i16_t*)(Vb + dh * 4096 + ks * 1024)));
                    const s16x4 vh = __builtin_bit_cast(s16x4, __builtin_amdgcn_ds_read_tr16_b64_v4i16((LAS v4i16_t*)(Vb + dh * 4096 + ks * 1024 + 512)));
                    const bf16x8 vf = {vl[0], vl[1], vl[2], vl[3], vh[0], vh[1], vh[2], vh[3]};
                    o[dh] = mfma32(vf, __builtin_bit_cast(bf16x8, pw[ks]), o[dh]);
                }
        }
        if (j + 1 < NT) { char* nb = lds + ((j + 1) & 1) * 8192; *(u32x4*)(nb + A_K + kwoff) = sk; *(u32x4*)(nb + A_V + vwoff) = sv; }
        __syncthreads();
    }
    l = swap_add(l);
    if (MODE == 1) l += __builtin_amdgcn_exp2f(P.sinkl2 - m);
    const float inv = 1.f / l;
    bf16_t* op = P.outp + ((size_t)P.b * SP + qpos) * P.opitch + P.ocol;
#pragma unroll
    for (int dh = 0; dh < 2; ++dh)
#pragma unroll
        for (int g4 = 0; g4 < 4; ++g4) {
            u32x2 w; w.x = cvtpk(o[dh][4 * g4] * inv, o[dh][4 * g4 + 1] * inv); w.y = cvtpk(o[dh][4 * g4 + 2] * inv, o[dh][4 * g4 + 3] * inv);
            *(u32x2*)(op + 32 * dh + 8 * g4 + 4 * hi) = w;
        }
#undef krow_of
}

__device__ void phase_attn0(const Ctx& C) {
    const int xcd = C.bid & 7, jx = C.bid >> 3;
    const int nper = C.nblk >> 3;
    for (int u = jx; u < 48 * 32 / 8; u += nper) {
        const int sl = xcd * 6 + u / 32, qb = u % 32;
        const int b = sl / 24, vh = sl % 24;
        AttnP P; P.b = b; P.q0 = qb * 256; P.kstart = 0; P.nt = SP / 64; P.sinkl2 = 0.f; P.head = 0;
        if (vh < 16) { const int h = vh >> 2, c = (vh >> 1) & 1, hf = vh & 1; P.qcol = (h * 2 + c) * 64; P.kcol = 1024 + (h * 2 + c) * 64; P.vcol = 1536 + h * 128 + hf * 64;
                       P.outp = WSP(bf16_t, WS_AO); P.opitch = D; P.ocol = (h * 2 + c) * 128 + hf * 64; }
        else { const int g = vh - 16; P.qcol = 512 + g * 64; P.kcol = 2048 + (g >> 2) * 64; P.vcol = 2176 + (g >> 2) * 64; P.outp = WSP(bf16_t, WS_ACT); P.opitch = D; P.ocol = 512 + g * 64; }
        attn_unit<0>(C, P);
    }
    for (int u = C.bid; u < 48; u += C.nblk) {
        const int b = u / 24, vh = u % 24;
        AttnP P; P.b = b; P.q0 = SEQ; P.kstart = SEQ; P.nt = NCTX / 64; P.sinkl2 = 0.f; P.head = 0;
        if (vh < 16) { const int h = vh >> 2, c = (vh >> 1) & 1, hf = vh & 1; P.qcol = (h * 2 + c) * 64; P.kcol = 1024 + (h * 2 + c) * 64; P.vcol = 1536 + h * 128 + hf * 64;
                       P.outp = WSP(bf16_t, WS_AO); P.opitch = D; P.ocol = (h * 2 + c) * 128 + hf * 64; }
        else { const int g = vh - 16; P.qcol = 512 + g * 64; P.kcol = 2048 + (g >> 2) * 64; P.vcol = 2176 + (g >> 2) * 64; P.outp = WSP(bf16_t, WS_ACT); P.opitch = D; P.ocol = 512 + g * 64; }
        attn_unit<0>(C, P);
    }
}

__device__ void phase_attn1(const Ctx& C) {
    for (int u = C.bid; u < 1024; u += C.nblk) {
        const int kind = u >> 9, v = u & 511, b = v >> 8, g = (v >> 5) & 7, qb = v & 31;
        AttnP P; P.b = b; P.q0 = qb * 256; P.kstart = 0; P.nt = 0; P.outp = WSP(bf16_t, WS_ACT); P.opitch = D; P.head = g;
        if (kind == 0) { P.qcol = g * 64; P.kcol = 1024 + (g >> 2) * 64; P.vcol = 1152 + (g >> 2) * 64; P.ocol = g * 64; P.sinkl2 = C.in[15][g] * LOG2E; attn_unit<1>(C, P); }
        else {
            P.qcol = 512 + g * 64; P.kcol = 1280 + g * 64; P.vcol = 1792 + g * 64; P.ocol = 512 + g * 64; P.sinkl2 = 0.f;
            __syncthreads();
            float* rp = (float*)(C.lds + A_RPB);
            for (int i = C.tid; i < 465; i += NTHR) rp[i] = C.in[16][g * 465 + i] * LOG2E;
            attn_unit<2>(C, P);
        }
    }
}

__device__ void phase_merge0(const Ctx& C) {
    const int lane = C.lane;
    const float* lv = C.in[10];
    const float sa = wave_sum(lv[lane] * lv[64 + lane]), sb = wave_sum(lv[128 + lane] * lv[192 + lane]);
    const float lam = expf(sa) - expf(sb) + 0.2f;
    const float g0 = C.in[11][2 * lane], g1 = C.in[11][2 * lane + 1];
    const bf16_t* ao = WSP(bf16_t, WS_AO); bf16_t* act = WSP(bf16_t, WS_ACT);
    for (int row = C.bid * 8 + C.wid; row < R; row += C.nblk * 8) {
#pragma unroll
        for (int h = 0; h < 4; ++h) {
            const unsigned a = *(const unsigned*)(ao + (size_t)row * D + (h * 2) * 128 + 2 * lane), b = *(const unsigned*)(ao + (size_t)row * D + (h * 2 + 1) * 128 + 2 * lane);
            const float d0 = bf2f((unsigned short)(a & 0xffff)) - lam * bf2f((unsigned short)(b & 0xffff)), d1 = bf2f((unsigned short)(a >> 16)) - lam * bf2f((unsigned short)(b >> 16));
            const float ss = wave_sum(d0 * d0 + d1 * d1);
            const float rinv = rsqrtf(ss * (1.f / 128.f) + 1e-6f) * 0.8f;
            *(unsigned*)(act + (size_t)row * D + h * 128 + 2 * lane) = cvtpk(d0 * rinv * g0, d1 * rinv * g1);
        }
    }
}

__device__ void phase_out(const Ctx& C, int layer) {
    const int tid = C.tid, lane = C.lane, wid = C.wid, r32 = lane & 31, hi = lane >> 5, wn = wid >> 2, wt = wid & 3;
    const bf16_t* Wt = WSP(bf16_t, WS_WOUT) + (size_t)layer * D * D;
    const bf16_t* act = WSP(bf16_t, WS_ACT);
    float* H = WSP(float, WS_H);
    const float* mods = WSP(float, WS_MODS) + (size_t)layer * 3 * 6144;
    const int c = tid & 7, r0 = tid >> 3;
    constexpr int NTT = R / 256, NNT = D / 128;
    for (int w = C.bid; w < NTT * NNT; w += C.nblk) {
        const int nt = w % NNT, tt = w / NNT;
        const bf16_t* rp[6];
        rp[0] = Wt + (size_t)(nt * 128 + r0) * D + c * 8; rp[1] = rp[0] + (size_t)64 * D;
#pragma unroll
        for (int i = 0; i < 4; ++i) rp[2 + i] = act + (size_t)(tt * 256 + r0 + 64 * i) * D + c * 8;
        f32x16 acc[2][2];
        gemm_core<16>(C.lds, rp, acc, tid);
#pragma unroll
        for (int ti = 0; ti < 2; ++ti) {
            const int tok = tt * 256 + wt * 64 + ti * 32 + r32;
            const float* hp = layer == 0 ? hin_row(C, tok) : H + (size_t)tok * D;
            const float* gate = mods + row_set(tok) * 6144 + 2 * 1024;
            float* op = H + (size_t)tok * D;
#pragma unroll
            for (int mi = 0; mi < 2; ++mi)
#pragma unroll
                for (int g4 = 0; g4 < 4; ++g4) {
                    const int n = nt * 128 + wn * 64 + mi * 32 + 8 * g4 + 4 * hi;
                    const f32x4 hv = *(const f32x4*)(hp + n), gv = *(const f32x4*)(gate + n);
                    f32x4 o; o[0] = ALPHA * hv[0] + gv[0] * acc[mi][ti][4 * g4]; o[1] = ALPHA * hv[1] + gv[1] * acc[mi][ti][4 * g4 + 1];
                    o[2] = ALPHA * hv[2] + gv[2] * acc[mi][ti][4 * g4 + 2]; o[3] = ALPHA * hv[3] + gv[3] * acc[mi][ti][4 * g4 + 3];
                    *(f32x4*)(op + n) = o;
                }
        }
    }
}

__device__ __forceinline__ int moe_row(int layer, int tok) { return layer == 0 ? tok : (tok >> 13) * SP + (tok & 8191); }
__device__ void phase_route(const Ctx& C, int layer) {
    const int tid = C.tid, lane = C.lane, wid = C.wid;
    float* Wl = (float*)C.lds;
    int* se0 = (int*)(C.lds + 147456); int* se1 = se0 + 128; float* sw0 = (float*)(se1 + 128); float* sw1 = sw0 + 128;
    int* cnt = (int*)(sw1 + 128); int* base = cnt + 32; int* sl0 = base + 32; int* sl1 = sl0 + 128;
    const float* wg = C.in[17] + (size_t)layer * D * 4; const float* wr = C.in[19] + (size_t)layer * D * 32;
    for (int i = tid; i < D * 36; i += NTHR) {
        const int k = i / 36, o = i - k * 36;
        const float v = o < 4 ? wg[k * 4 + o] : wr[k * 32 + o - 4];
        Wl[(((k & 3) << 8) + (k >> 2)) * 36 + o] = v;
    }
    if (tid < 32) cnt[tid] = 0;
    __syncthreads();
    const int T = layer == 0 ? R : NB * SEQ;
    const int chunk = (T + C.nblk - 1) / C.nblk;
    const int t0 = C.bid * chunk, t1 = t0 + chunk < T ? t0 + chunk : T;
    float* H = WSP(float, WS_H); bf16_t* act = WSP(bf16_t, WS_ACT);
    const float* lng = C.in[6] + (size_t)(layer * 2 + 0) * D; const float* lnb = C.in[7] + (size_t)(layer * 2 + 0) * D;
    const float* bg = C.in[18] + layer * 4; const float* br = C.in[20] + layer * 32;
    for (int tk = t0 + wid; tk < t1; tk += 8) {
        const int row = moe_row(layer, tk);
        const float* m = WSP(float, WS_MODS) + (size_t)(layer * 3 + row_set(row)) * 6144;
        float* hr = H + (size_t)row * D;
        f32x4 x[4]; float s = 0.f;
#pragma unroll
        for (int i = 0; i < 4; ++i) { x[i] = *(const f32x4*)(hr + lane * 4 + 256 * i); s += (x[i][0] + x[i][1]) + (x[i][2] + x[i][3]); }
        const float mean = wave_sum(s) * (1.f / 1024.f);
        float q = 0.f;
#pragma unroll
        for (int i = 0; i < 4; ++i) { x[i] -= mean; q += (x[i][0] * x[i][0] + x[i][1] * x[i][1]) + (x[i][2] * x[i][2] + x[i][3] * x[i][3]); }
        const float rstd = rsqrtf(wave_sum(q) * (1.f / 1024.f) + 1e-5f);
        f32x4 f[4];
#pragma unroll
        for (int i = 0; i < 4; ++i) {
            const int col = lane * 4 + 256 * i;
            const f32x4 g = *(const f32x4*)(lng + col), bb = *(const f32x4*)(lnb + col);
            const f32x4 hv = x[i] * rstd * g + bb;
            *(f32x4*)(hr + col) = hv;
            const f32x4 sh = *(const f32x4*)(m + 3 * 1024 + col), sc = *(const f32x4*)(m + 4 * 1024 + col);
            f[i] = hv * (1.f + sc) + sh;
            u32x2 o; o.x = cvtpk(f[i][0], f[i][1]); o.y = cvtpk(f[i][2], f[i][3]);
            *(u32x2*)(act + (size_t)row * D + col) = o;
        }
        f32x4 gl = {0, 0, 0, 0};
#pragma unroll
        for (int i = 0; i < 4; ++i)
#pragma unroll
            for (int cc = 0; cc < 4; ++cc) gl += f[i][cc] * *(const f32x4*)(Wl + (cc * 256 + 64 * i + lane) * 36);
        float g0 = wave_sum(gl[0]) + bg[0], g1 = wave_sum(gl[1]) + bg[1], g2 = wave_sum(gl[2]) + bg[2], g3 = wave_sum(gl[3]) + bg[3];
        int gi = 0; float gm = g0;
        if (g1 > gm) { gm = g1; gi = 1; } if (g2 > gm) { gm = g2; gi = 2; } if (g3 > gm) { gm = g3; gi = 3; }
        const float gw = 1.f / (expf(g0 - gm) + expf(g1 - gm) + expf(g2 - gm) + expf(g3 - gm));
        f32x4 ea = {0, 0, 0, 0}, eb = ea;
#pragma unroll
        for (int i = 0; i < 4; ++i)
#pragma unroll
            for (int cc = 0; cc < 4; ++cc) {
                const float* wp = Wl + (cc * 256 + 64 * i + lane) * 36 + 4 + 8 * gi;
                ea += f[i][cc] * *(const f32x4*)(wp); eb += f[i][cc] * *(const f32x4*)(wp + 4);
            }
        float ev[8];
#pragma unroll
        for (int k = 0; k < 4; ++k) { ev[k] = wave_sum(ea[k]) + br[gi * 8 + k]; ev[4 + k] = wave_sum(eb[k]) + br[gi * 8 + 4 + k]; }
        int i0 = 0; float v0 = ev[0];
#pragma unroll
        for (int k = 1; k < 8; ++k) if (ev[k] > v0) { v0 = ev[k]; i0 = k; }
        int i1 = -1; float v1 = -3.0e38f;
#pragma unroll
        for (int k = 0; k < 8; ++k) if (k != i0 && ev[k] > v1) { v1 = ev[k]; i1 = k; }
        const float e = expf(v1 - v0);
        if (lane == 0) { const int li = tk - t0; se0[li] = gi * 8 + i0; se1[li] = gi * 8 + i1; sw0[li] = gw / (1.f + e); sw1[li] = gw * e / (1.f + e); }
    }
    __syncthreads();
    const int nloc = t1 - t0;
    if (tid < 2 * nloc) { const int li = tid >> 1; const int e = (tid & 1) ? se1[li] : se0[li]; const int s = atomicAdd(&cnt[e], 1); if (tid & 1) sl1[li] = s; else sl0[li] = s; }
    __syncthreads();
    unsigned* gc = (unsigned*)(C.ws + WS_CTL) + CW_CNT + layer * 64;
    if (tid < 32) base[tid] = cnt[tid] > 0 ? (int)atomicAdd(&gc[tid], (unsigned)cnt[tid]) : 0;
    __syncthreads();
    int* perm = WSP(int, WS_PERM); int* tokinfo = WSP(int, WS_TOK);
    if (tid < nloc) {
        const int li = tid, row = moe_row(layer, t0 + li);
        const int e0 = se0[li], e1 = se1[li], s0 = base[e0] + sl0[li], s1 = base[e1] + sl1[li];
        perm[e0 * CAP + s0] = row; perm[e1 * CAP + s1] = row;
        int* ti = tokinfo + (size_t)row * 8;
        ti[0] = e0; ti[1] = s0; ti[2] = e1; ti[3] = s1; ti[4] = __float_as_int(sw0[li]); ti[5] = __float_as_int(sw1[li]);
    }
    __syncthreads();
}

struct MoeTab { int* cnt; int* off; int* tp; };
__device__ __forceinline__ MoeTab moe_tables(const Ctx& C, int layer, int ldsoff) {
    MoeTab M; M.cnt = (int*)(C.lds + ldsoff); M.off = M.cnt + 32; M.tp = M.off + 33;
    __syncthreads();
    if (C.tid == 0) {
        unsigned* gc = (unsigned*)(C.ws + WS_CTL) + CW_CNT + layer * 64;
        int o = 0, t = 0;
        for (int e = 0; e < 32; ++e) { const int c = (int)__hip_atomic_load(&gc[e], __ATOMIC_RELAXED, __HIP_MEMORY_SCOPE_AGENT); M.cnt[e] = c; M.off[e] = o; M.tp[e] = t; o += c; t += (c + 255) >> 8; }
        M.off[32] = o; M.tp[32] = t;
    }
    __syncthreads();
    return M;
}

__device__ void phase_moe1(const Ctx& C, int layer) {
    const int tid = C.tid, lane = C.lane, wid = C.wid, r32 = lane & 31, hi = lane >> 5, wn = wid >> 2, wt = wid & 3;
    const MoeTab M = moe_tables(C, layer, 2 * GSTAGE);
    const bf16_t* act = WSP(bf16_t, WS_ACT); const int* perm = WSP(int, WS_PERM);
    bf16_t* hb = WSP(bf16_t, WS_HB);
    const int c = tid & 7, r0 = tid >> 3;
    const int TT = M.tp[32];
    for (int w = C.bid; w < TT * 8; w += C.nblk) {
        const int ttile = w >> 3, nt = w & 7;
        int e = 0;
        for (int k = 1; k < 32; ++k) if (M.tp[k] <= ttile) e = k;
        const int lt = ttile - M.tp[e], cnt = M.cnt[e];
        const bf16_t* rp[6];
#pragma unroll
        for (int i = 0; i < 2; ++i) {
            const int r = r0 + 64 * i, wn_ = r >> 6, mi = (r >> 5) & 1, rr = r & 31;
            const bf16_t* Wb = mi ? WSP(bf16_t, WS_W3) : WSP(bf16_t, WS_W1);
            rp[i] = Wb + ((size_t)(layer * 32 + e) * 512 + nt * 64 + wn_ * 32 + rr) * D + c * 8;
        }
#pragma unroll
        for (int i = 0; i < 4; ++i) {
            int slot = lt * 256 + r0 + 64 * i; slot = slot < cnt ? slot : cnt - 1;
            rp[2 + i] = act + (size_t)perm[e * CAP + slot] * D + c * 8;
        }
        f32x16 acc[2][2];
        gemm_core<16>(C.lds, rp, acc, tid);
#pragma unroll
        for (int ti = 0; ti < 2; ++ti) {
            const int slot = lt * 256 + wt * 64 + ti * 32 + r32;
            if (slot < cnt) {
                bf16_t* op = hb + (size_t)(M.off[e] + slot) * 512 + nt * 64 + wn * 32;
#pragma unroll
                for (int g4 = 0; g4 < 4; ++g4) {
                    float hv[4];
#pragma unroll
                    for (int i = 0; i < 4; ++i) hv[i] = silu_f(acc[0][ti][4 * g4 + i]) * acc[1][ti][4 * g4 + i];
                    u32x2 o; o.x = cvtpk(hv[0], hv[1]); o.y = cvtpk(hv[2], hv[3]);
                    *(u32x2*)(op + 8 * g4 + 4 * hi) = o;
                }
            }
        }
    }
}

__device__ void phase_moe2(const Ctx& C, int layer) {
    const int tid = C.tid, lane = C.lane, wid = C.wid, r32 = lane & 31, hi = lane >> 5, wn = wid >> 2, wt = wid & 3;
    const MoeTab M = moe_tables(C, layer, 2 * GSTAGE);
    const bf16_t* hb = WSP(bf16_t, WS_HB); bf16_t* yb = WSP(bf16_t, WS_YB);
    const int c = tid & 7, r0 = tid >> 3;
    const int TT = M.tp[32];
    for (int w = C.bid; w < TT * 8; w += C.nblk) {
        const int ttile = w >> 3, nt = w & 7;
        int e = 0;
        for (int k = 1; k < 32; ++k) if (M.tp[k] <= ttile) e = k;
        const int lt = ttile - M.tp[e], cnt = M.cnt[e];
        const bf16_t* rp[6];
        rp[0] = WSP(bf16_t, WS_W2) + ((size_t)(layer * 32 + e) * 1024 + nt * 128 + r0) * 512 + c * 8; rp[1] = rp[0] + (size_t)64 * 512;
#pragma unroll
        for (int i = 0; i < 4; ++i) {
            int slot = lt * 256 + r0 + 64 * i; slot = slot < cnt ? slot : cnt - 1;
            rp[2 + i] = hb + (size_t)(M.off[e] + slot) * 512 + c * 8;
        }
        f32x16 acc[2][2];
        gemm_core<8>(C.lds, rp, acc, tid);
#pragma unroll
        for (int ti = 0; ti < 2; ++ti) {
            const int slot = lt * 256 + wt * 64 + ti * 32 + r32;
            if (slot < cnt) {
                bf16_t* op = yb + (size_t)(M.off[e] + slot) * D + nt * 128 + wn * 64;
#pragma unroll
                for (int mi = 0; mi < 2; ++mi)
#pragma unroll
                    for (int g4 = 0; g4 < 4; ++g4) {
                        u32x2 o; o.x = cvtpk(acc[mi][ti][4 * g4], acc[mi][ti][4 * g4 + 1]); o.y = cvtpk(acc[mi][ti][4 * g4 + 2], acc[mi][ti][4 * g4 + 3]);
                        *(u32x2*)(op + mi * 32 + 8 * g4 + 4 * hi) = o;
                    }
            }
        }
    }
}

__device__ void phase_final(const Ctx& C, int layer) {
    const int lane = C.lane;
    const MoeTab M = moe_tables(C, layer, 0);
    float* H = WSP(float, WS_H); const bf16_t* yb = WSP(bf16_t, WS_YB); const int* tokinfo = WSP(int, WS_TOK);
    bf16_t* act = WSP(bf16_t, WS_ACT);
    const float* lng = C.in[6] + (size_t)(layer * 2 + 1) * D; const float* lnb = C.in[7] + (size_t)(layer * 2 + 1) * D;
    const int T = layer == 0 ? R : NB * SEQ;
    for (int tk = C.bid * 8 + C.wid; tk < T; tk += C.nblk * 8) {
        const int row = moe_row(layer, tk), set = row_set(row);
        const int* ti = tokinfo + (size_t)row * 8;
        const int e0 = ti[0], s0 = ti[1], e1 = ti[2], s1 = ti[3]; const float w0 = __int_as_float(ti[4]), w1 = __int_as_float(ti[5]);
        const bf16_t* y0 = yb + (size_t)(M.off[e0] + s0) * D; const bf16_t* y1 = yb + (size_t)(M.off[e1] + s1) * D;
        const float* m = WSP(float, WS_MODS) + (size_t)(layer * 3 + set) * 6144;
        float* hr = H + (size_t)row * D;
        f32x4 x[4]; float s = 0.f;
#pragma unroll
        for (int i = 0; i < 4; ++i) {
            const int col = lane * 4 + 256 * i;
            const f32x4 hv = *(const f32x4*)(hr + col), g5 = *(const f32x4*)(m + 5 * 1024 + col);
            const u32x2 a = *(const u32x2*)(y0 + col), b = *(const u32x2*)(y1 + col);
            f32x4 y;
            y[0] = w0 * bf2f((unsigned short)(a.x & 0xffff)) + w1 * bf2f((unsigned short)(b.x & 0xffff)); y[1] = w0 * bf2f((unsigned short)(a.x >> 16)) + w1 * bf2f((unsigned short)(b.x >> 16));
            y[2] = w0 * bf2f((unsigned short)(a.y & 0xffff)) + w1 * bf2f((unsigned short)(b.y & 0xffff)); y[3] = w0 * bf2f((unsigned short)(a.y >> 16)) + w1 * bf2f((unsigned short)(b.y >> 16));
            x[i] = ALPHA * hv + g5 * y;
            s += (x[i][0] + x[i][1]) + (x[i][2] + x[i][3]);
        }
        const float mean = wave_sum(s) * (1.f / 1024.f);
        float q = 0.f;
#pragma unroll
        for (int i = 0; i < 4; ++i) { x[i] -= mean; q += (x[i][0] * x[i][0] + x[i][1] * x[i][1]) + (x[i][2] * x[i][2] + x[i][3] * x[i][3]); }
        const float rstd = rsqrtf(wave_sum(q) * (1.f / 1024.f) + 1e-5f);
        const float* mn = WSP(float, WS_MODS) + (size_t)(3 + set) * 6144;
#pragma unroll
        for (int i = 0; i < 4; ++i) {
            const int col = lane * 4 + 256 * i;
            const f32x4 g = *(const f32x4*)(lng + col), bb = *(const f32x4*)(lnb + col);
            const f32x4 hv = x[i] * rstd * g + bb;
            if (layer == 0) {
                *(f32x4*)(hr + col) = hv;
                const f32x4 sh = *(const f32x4*)(mn + col), sc = *(const f32x4*)(mn + 1024 + col);
                const f32x4 a = hv * (1.f + sc) + sh;
                u32x2 o; o.x = cvtpk(a[0], a[1]); o.y = cvtpk(a[2], a[3]);
                *(u32x2*)(act + (size_t)row * D + col) = o;
            } else {
                *(f32x4*)(C.out + (size_t)tk * D + col) = hv;
            }
        }
    }
}

constexpr int NPHASE = 17;
#ifndef PH_ONLY
#define PH_EN(k) true
#else
#define PH_EN(k) ((k) == PH_ONLY)
#endif
__global__ void __launch_bounds__(NTHR, 2) mega(Args args) {
    extern __shared__ __attribute__((aligned(16))) char lds[];
    Ctx C; C.lds = lds; C.tid = threadIdx.x; C.lane = C.tid & 63; C.wid = __builtin_amdgcn_readfirstlane(C.tid >> 6);
    C.bid = blockIdx.x; C.nblk = gridDim.x; C.in = args.in; C.out = args.out; C.ws = args.ws;
    volatile LAS unsigned* bst = (volatile LAS unsigned*)(LAS char*)(lds + LDS_BYTES - 64);
    if (C.tid < 2) bst[C.tid] = 0u;
    __syncthreads();
    const bool single = (args.ph_hi - args.ph_lo) > 1;
    XcdBarrier bar; bar.bar = (unsigned*)(C.ws + WS_CTL) + CW_BAR; bar.x = 0; bar.st = bst;
    if (single) bar = xcd_barrier_post((unsigned*)(C.ws + WS_CTL) + CW_BAR, bst);
    const int lo = args.ph_lo, hi = args.ph_hi;
#define RUN(k, call) if (lo <= (k) && (k) < hi) { if (PH_EN(k)) { call; } if (single && (k) + 1 < hi) xcd_barrier(bar); else __syncthreads(); }
    RUN(0, phase_prologue(C))
    RUN(1, phase_mod0(C))
    RUN(2, phase_proj(C, 0))
    RUN(3, phase_attn0(C))
    RUN(4, phase_merge0(C))
    RUN(5, phase_out(C, 0))
    RUN(6, phase_route(C, 0))
    RUN(7, phase_moe1(C, 0))
    RUN(8, phase_moe2(C, 0))
    RUN(9, phase_final(C, 0))
    RUN(10, phase_proj(C, 1))
    RUN(11, phase_attn1(C))
    RUN(12, phase_out(C, 1))
    RUN(13, phase_route(C, 1))
    RUN(14, phase_moe1(C, 1))
    RUN(15, phase_moe2(C, 1))
    RUN(16, phase_final(C, 1))
#undef RUN
}

extern "C" void kernel_launch(void* const* d_in, const int* in_sizes, int n_in, void* d_out, int out_size, void* d_ws, size_t ws_size, hipStream_t stream) {
    static int grid = 0;
    if (grid == 0) {
        if (n_in != 24 || ws_size < WS_END) { fprintf(stderr, "kernel_launch: unexpected n_in %d / ws_size %zu (need %zu)\n", n_in, ws_size, (size_t)WS_END); grid = -1; return; }
        int dev = 0, cus = 0, per_cu = 0;
        hipGetDevice(&dev);
        hipDeviceGetAttribute(&cus, hipDeviceAttributeMultiprocessorCount, dev);
        hipFuncSetAttribute((const void*)mega, hipFuncAttributeMaxDynamicSharedMemorySize, LDS_BYTES);
        hipOccupancyMaxActiveBlocksPerMultiprocessor(&per_cu, (const void*)mega, NTHR, LDS_BYTES);
        (void)hipGetLastError();
        if (per_cu < 1) fprintf(stderr, "kernel_launch: occupancy query says %d blocks/CU\n", per_cu);
        grid = cus;
    }
    if (grid < 0) return;
    hipMemsetAsync((char*)d_ws + WS_CTL, 0, CTL_BYTES, stream);
    Args a{};
    for (int i = 0; i < 24; ++i) a.in[i] = (const float*)d_in[i];
    a.out = (float*)d_out; a.ws = (unsigned char*)d_ws;
#if MK_SINGLE
    a.ph_lo = 0; a.ph_hi = NPHASE;
    void* kargs[] = {&a};
    hipLaunchCooperativeKernel((const void*)mega, dim3(grid), dim3(NTHR), kargs, LDS_BYTES, stream);
#else
    for (int ph = 0; ph < NPHASE; ++ph) {
        a.ph_lo = ph; a.ph_hi = ph + 1;
        hipLaunchKernelGGL(mega, dim3(grid), dim3(NTHR), LDS_BYTES, stream, a);
    }
#endif
}
```

```cpp
#include <hip/hip_runtime.h>
#include <stdint.h>
#include <stdio.h>

#ifndef MK_SINGLE
#define MK_SINGLE 1
#endif

typedef unsigned short bf16_t;
typedef short bf16x8 __attribute__((ext_vector_type(8)));
typedef short s16x4 __attribute__((ext_vector_type(4)));
typedef short v4i16_t __attribute__((ext_vector_type(4)));
typedef float f32x16 __attribute__((ext_vector_type(16)));
typedef float f32x4 __attribute__((ext_vector_type(4)));
typedef float f32x2 __attribute__((ext_vector_type(2)));
typedef __bf16 bf16x2_t __attribute__((ext_vector_type(2)));
typedef unsigned u32x4 __attribute__((ext_vector_type(4)));
typedef unsigned u32x2 __attribute__((ext_vector_type(2)));
#define LAS __attribute__((address_space(3)))

constexpr int D = 1024, NB = 2, SEQ = 8192, NCTX = 256, SP = SEQ + NCTX  , R = NB * SP  ;
constexpr int NQKV = 2304, NTHR = 512, CAP = R;
constexpr float ALPHA = 1.4142135623730951f;
constexpr float LOG2E = 1.4426950408889634f;
constexpr float C2 = 0.125f * LOG2E;
constexpr float NEGBIG = -1e30f;

constexpr size_t MiB = 1u << 20;
constexpr size_t WS_CTL = 0, CTL_BYTES = 1 * MiB;
constexpr size_t WS_MODS = 1 * MiB;
constexpr size_t WS_ROPE = 2 * MiB;
constexpr size_t WS_WIN = 4 * MiB;
constexpr size_t WS_WOUT = 13 * MiB;
constexpr size_t WS_W1 = 18 * MiB;
constexpr size_t WS_W3 = 82 * MiB;
constexpr size_t WS_W2 = 146 * MiB;
constexpr size_t WS_ACT = 210 * MiB;
constexpr size_t WS_H = 243 * MiB;
constexpr size_t WS_QKV = 309 * MiB;
constexpr size_t WS_AO = 384 * MiB;
constexpr size_t WS_TOK = 417 * MiB;
constexpr size_t WS_PERM = 418 * MiB;
constexpr size_t WS_HB = 309 * MiB;
constexpr size_t WS_YB = 343 * MiB;
constexpr size_t WS_WG = 421 * MiB;
constexpr size_t WS_END = 433 * MiB;
constexpr int CW_BAR = 4096, CW_CNT = 16384;

constexpr int LDS_BYTES = 155648;

__device__ __forceinline__ unsigned cvtpk(float lo, float hi) { f32x2 v = {lo, hi}; bf16x2_t b = __builtin_convertvector(v, bf16x2_t); return __builtin_bit_cast(unsigned, b); }
__device__ __forceinline__ bf16_t f2bf(float f) { unsigned u = __builtin_bit_cast(unsigned, f); return (bf16_t)((u + 0x7fffu + ((u >> 16) & 1u)) >> 16); }
__device__ __forceinline__ float bf2f(unsigned short h) { return __builtin_bit_cast(float, (unsigned)h << 16); }
__device__ __forceinline__ int crow(int r, int hi) { return (r & 3) + 8 * (r >> 2) + 4 * hi; }
__device__ __forceinline__ float wave_sum(float v) {
#pragma unroll
    for (int o = 1; o < 64; o <<= 1) v += __shfl_xor(v, o);
    return v;
}
__device__ __forceinline__ float rdlane(float v, int l) { return __int_as_float(__builtin_amdgcn_readlane(__float_as_int(v), l)); }
__device__ __forceinline__ void wave_sum2(float& a, float& b, int lane) {
    const bool b0 = lane & 1;
    float k = b0 ? b : a; const float sd = b0 ? a : b;
    k += __shfl_xor(sd, 1);
#pragma unroll
    for (int o = 2; o < 64; o <<= 1) k += __shfl_xor(k, o);
    a = rdlane(k, 0); b = rdlane(k, 1);
}
__device__ __forceinline__ f32x4 wave_sum4(f32x4 v, int lane) {
    const bool b0 = lane & 1, b1 = lane & 2;
    float k0 = b0 ? v[2] : v[0], k1 = b0 ? v[3] : v[1]; const float s0 = b0 ? v[0] : v[2], s1 = b0 ? v[1] : v[3];
    k0 += __shfl_xor(s0, 1); k1 += __shfl_xor(s1, 1);
    float k = b1 ? k1 : k0; const float sd = b1 ? k0 : k1;
    k += __shfl_xor(sd, 2);
#pragma unroll
    for (int o = 4; o < 64; o <<= 1) k += __shfl_xor(k, o);
    f32x4 r; r[0] = rdlane(k, 0); r[1] = rdlane(k, 2); r[2] = rdlane(k, 1); r[3] = rdlane(k, 3);
    return r;
}
__device__ __forceinline__ void wave_sum8(f32x4 lo, f32x4 hi_, float (&out)[8], int lane) {
    const bool b0 = lane & 1, b1 = lane & 2, b2 = lane & 4;
    f32x4 k = b0 ? hi_ : lo; const f32x4 sd = b0 ? lo : hi_;
#pragma unroll
    for (int i = 0; i < 4; ++i) k[i] += __shfl_xor(sd[i], 1);
    float k0 = b1 ? k[2] : k[0], k1 = b1 ? k[3] : k[1]; const float s0 = b1 ? k[0] : k[2], s1 = b1 ? k[1] : k[3];
    k0 += __shfl_xor(s0, 2); k1 += __shfl_xor(s1, 2);
    float kk = b2 ? k1 : k0; const float s2 = b2 ? k0 : k1;
    kk += __shfl_xor(s2, 4);
#pragma unroll
    for (int o = 8; o < 64; o <<= 1) kk += __shfl_xor(kk, o);
#pragma unroll
    for (int j = 0; j < 8; ++j) out[j] = rdlane(kk, (j >> 2) + 2 * ((j >> 1) & 1) + 4 * (j & 1));
}
__device__ __forceinline__ float swap_add(float v) { auto rr = __builtin_amdgcn_permlane32_swap(__float_as_uint(v), __float_as_uint(v), false, false); return __uint_as_float(rr[0]) + __uint_as_float(rr[1]); }
__device__ __forceinline__ float swap_max(float v) { auto rr = __builtin_amdgcn_permlane32_swap(__float_as_uint(v), __float_as_uint(v), false, false); return fmaxf(__uint_as_float(rr[0]), __uint_as_float(rr[1])); }
__device__ __forceinline__ f32x16 mfma32(bf16x8 a, bf16x8 b, f32x16 c) { return __builtin_amdgcn_mfma_f32_32x32x16_bf16(a, b, c, 0, 0, 0); }
__device__ __forceinline__ float silu_f(float x) { return x * __builtin_amdgcn_rcpf(1.f + __builtin_amdgcn_exp2f(x * -1.4426950408889634f)); }

#define XB_TMO      128
#define XB_XCNT(j)  (256  + 64 * (j))
#define XB_XSUB(j)  (1280 + 64 * (j))
#define XB_XGEN(j)  (2304 + 64 * (j))
#define XB_TOP      3328
#define XB_TOPGEN   3392
#define XCD_BAR_WORDS 3456
#define XB_SPIN_CAP (1u << 20)
__device__ __forceinline__ unsigned xb_ld(unsigned* p)              { return __hip_atomic_load(p, __ATOMIC_RELAXED, __HIP_MEMORY_SCOPE_AGENT); }
__device__ __forceinline__ unsigned xb_add(unsigned* p, unsigned v) { return __hip_atomic_fetch_add(p, v, __ATOMIC_RELAXED, __HIP_MEMORY_SCOPE_AGENT); }
__device__ __forceinline__ unsigned xb_xcc_id() { return (unsigned)__builtin_amdgcn_s_getreg((3 << 11) | 20) & 0xFu; }
#define XB_SPIN(cond, bar) do { unsigned _sp = 0; while (cond) { __builtin_amdgcn_s_sleep(1); \
    if ((++_sp & 255u) == 0u) { if (xb_ld(&(bar)[XB_TMO])) break; if (_sp > XB_SPIN_CAP) { atomicAdd(&(bar)[XB_TMO], 1u); break; } } } } while (0)
struct XcdBarrier { unsigned* bar; unsigned x; volatile LAS unsigned* st; };
__device__ __forceinline__ XcdBarrier xcd_barrier_post(unsigned* bar, volatile LAS unsigned* st) {
    XcdBarrier b; b.bar = bar; b.x = xb_xcc_id(); b.st = st;
    if (threadIdx.x == 0) st[2] = xb_add(&bar[XB_XCNT(b.x)], 1u);
    return b;
}
__device__ __forceinline__ void xcd_barrier_complete(unsigned* bar, unsigned x, unsigned& nloc, unsigned& nx) {
    const unsigned G = gridDim.x * gridDim.y * gridDim.z;
    unsigned sum, cnt, mine, sp = 0u;
    for (;;) {
        sum = 0u; cnt = 0u; mine = 0u;
#pragma unroll
        for (unsigned j = 0; j < 16; ++j) { const unsigned c = xb_ld(&bar[XB_XCNT(j)]); sum += c; cnt += (c > 0u) ? 1u : 0u; mine = (j == x) ? c : mine; }
        if (sum == G) break;
        __builtin_amdgcn_s_sleep(1);
        if ((++sp & 255u) == 0u) { if (xb_ld(&bar[XB_TMO])) break; if (sp > XB_SPIN_CAP) { atomicAdd(&bar[XB_TMO], 1u); break; } }
    }
    nloc = mine > 0u ? mine : 1u; nx = cnt > 0u ? cnt : 1u;
}
__device__ __forceinline__ void xcd_barrier(const XcdBarrier& b) {
    asm volatile("s_waitcnt vmcnt(0)" ::: "memory");
    __syncthreads();
    if (threadIdx.x == 0) {
        unsigned* bar = b.bar;
        __builtin_amdgcn_s_waitcnt(0);
        unsigned nloc = b.st[0], nx = b.st[1];
        if (nloc == 0u) { xcd_barrier_complete(bar, b.x, nloc, nx); b.st[0] = nloc; b.st[1] = nx; }
        const unsigned old = xb_add(&bar[XB_XSUB(b.x)], 1u);
        const unsigned gen = old / nloc;
        if (old + 1u == (gen + 1u) * nloc) {
            __builtin_amdgcn_fence(__ATOMIC_RELEASE, "agent");
            asm volatile("s_waitcnt vmcnt(0)" ::: "memory");
            const unsigned og = xb_add(&bar[XB_TOP], 1u);
            const unsigned tg = og / nx;
            asm volatile("buffer_inv sc1" ::: "memory");
            if (og + 1u == (tg + 1u) * nx) xb_add(&bar[XB_TOPGEN], 1u);
            else XB_SPIN(xb_ld(&bar[XB_TOPGEN]) == tg, bar);
            xb_add(&bar[XB_XGEN(b.x)], 1u);
            asm volatile("s_waitcnt vmcnt(0)" ::: "memory");
        } else {
            asm volatile("buffer_inv sc1" ::: "memory");
            XB_SPIN(xb_ld(&bar[XB_XGEN(b.x)]) == gen, bar);
            asm volatile("s_waitcnt vmcnt(0)" ::: "memory");
        }
    }
    __syncthreads();
}

__device__ __forceinline__ void st16_wt(void* p, u32x4 v) { asm volatile("global_store_dwordx4 %0, %1, off sc1\n\ts_nop 1" :: "v"(p), "v"(v) : "memory"); }
#define ATTN_STORE16(p,v) st16_wt((void*)(p), (v))
#include <hip/hip_bf16.h>
#include <cmath>
namespace attn_body {
using bf16=__hip_bfloat16;
using bf16x8=__attribute__((ext_vector_type(8)))short;
using s16x4=__attribute__((ext_vector_type(4)))short;
using f32x16=__attribute__((ext_vector_type(16)))float;
using u32x4=__attribute__((ext_vector_type(4)))unsigned;
constexpr int D=64;
constexpr int NW=8,QBLK=32,QB=QBLK*NW,KVBLK=64;
__device__ __forceinline__ int crow(int r,int hi){return (r&3)+8*(r>>2)+4*hi;}
#define SBAR() __builtin_amdgcn_sched_barrier(0)
constexpr int NSLOT=3, SLOTB=8192;
constexpr int LDS_K=0, LDS_V=NSLOT*SLOTB, LDS_WS=2*NSLOT*SLOTB, LDS_OST=LDS_WS+NW*64*4, LDS_BYTES=LDS_OST+NW*4096;
constexpr float C2=0.125f*1.4426950408889634f;
__device__ __forceinline__ void glds16(const void*gsrc,unsigned lds_dst){unsigned keep;
  asm volatile("s_mov_b32 %0, m0\n\ts_mov_b32 m0, %2\n\ts_nop 0\n\tglobal_load_lds_dwordx4 %1, off\n\ts_mov_b32 m0, %0":"=&s"(keep):"v"(gsrc),"s"(lds_dst):"memory");}
__device__ __forceinline__ float max3f(float a,float b,float c){float r;asm("v_max3_f32 %0, %1, %2, %3":"=v"(r):"v"(a),"v"(b),"v"(c));return r;}
__device__ __forceinline__ float max2f(float a,float b){float r;asm("v_max_f32_e32 %0, %1, %2":"=v"(r):"v"(a),"v"(b));return r;}
__device__ __forceinline__ float fadd_s(float a,float b){float r;asm("v_add_f32_e32 %0, %1, %2":"=v"(r):"v"(a),"v"(b));return r;}
__device__ __forceinline__ float fsub_s(float a,float b){float r;asm("v_sub_f32_e32 %0, %1, %2":"=v"(r):"v"(a),"v"(b));return r;}
typedef float f32x2_t __attribute__((ext_vector_type(2))); typedef __bf16 bf16x2_t __attribute__((ext_vector_type(2)));
__device__ __forceinline__ unsigned cvtpk_s(float lo,float hi){f32x2_t v={lo,hi};bf16x2_t b=__builtin_convertvector(v,bf16x2_t);return __builtin_bit_cast(unsigned,b);}
#define WAIT_BAR(N) asm volatile("s_waitcnt vmcnt(" #N ") lgkmcnt(0)\n\ts_barrier":::"memory")

__device__ __forceinline__ void qkt(f32x16&p0,f32x16&p1,const char*Kslot,const bf16x8*qr,const f32x16&negm,int r32,int hi){
  const char*kb=Kslot+hi*1024+r32*16;
  #pragma unroll
  for(int d0=0;d0<4;++d0){
    const bf16x8 b0=*reinterpret_cast<const bf16x8*>(kb+d0*2048);
    const bf16x8 b1=*reinterpret_cast<const bf16x8*>(kb+d0*2048+512);
    if(d0==0){p0=__builtin_amdgcn_mfma_f32_32x32x16_bf16(b0,qr[0],negm,0,0,0);p1=__builtin_amdgcn_mfma_f32_32x32x16_bf16(b1,qr[0],negm,0,0,0);}
    else{p0=__builtin_amdgcn_mfma_f32_32x32x16_bf16(b0,qr[d0],p0,0,0,0);p1=__builtin_amdgcn_mfma_f32_32x32x16_bf16(b1,qr[d0],p1,0,0,0);}}
}
typedef __attribute__((address_space(3))) const char* lds_cptr;
typedef short v4i16_t __attribute__((ext_vector_type(4)));
__device__ __forceinline__ void kload8(bf16x8*kf,lds_cptr kp){
  kf[0]=*(const __attribute__((address_space(3))) bf16x8*)(kp);      kf[1]=*(const __attribute__((address_space(3))) bf16x8*)(kp+512);
  kf[2]=*(const __attribute__((address_space(3))) bf16x8*)(kp+2048); kf[3]=*(const __attribute__((address_space(3))) bf16x8*)(kp+2560);
  kf[4]=*(const __attribute__((address_space(3))) bf16x8*)(kp+4096); kf[5]=*(const __attribute__((address_space(3))) bf16x8*)(kp+4608);
  kf[6]=*(const __attribute__((address_space(3))) bf16x8*)(kp+6144); kf[7]=*(const __attribute__((address_space(3))) bf16x8*)(kp+6656);
}
__device__ __forceinline__ void kload2(bf16x8*kf,lds_cptr kp,int j){ kf[2*j]=*(const __attribute__((address_space(3))) bf16x8*)(kp+j*2048); kf[2*j+1]=*(const __attribute__((address_space(3))) bf16x8*)(kp+j*2048+512); }
__device__ __forceinline__ s16x4 vtr(lds_cptr p){ return __builtin_bit_cast(s16x4,__builtin_amdgcn_ds_read_tr16_b64_v4i16((__attribute__((address_space(3))) v4i16_t*)p)); }
__device__ __forceinline__ float rowmax(const f32x16&p0,const f32x16&p1){
  float a=max3f(p0[0],p0[1],p1[0]),b=max3f(p0[2],p0[3],p1[1]);a=max3f(a,p1[2],p1[3]);
  #pragma unroll
  for(int r=4;r<16;r+=4){a=max3f(a,p0[r],p0[r+1]);b=max3f(b,p0[r+2],p0[r+3]);a=max3f(a,p1[r],p1[r+1]);b=max3f(b,p1[r+2],p1[r+3]);}
  const float m=max2f(a,b);
  auto rr=__builtin_amdgcn_permlane32_swap(__float_as_uint(m),__float_as_uint(m),false,false);
  return max2f(__uint_as_float(rr[0]),__uint_as_float(rr[1]));
}
__device__ __forceinline__ void pv(f32x16*o,int vb,bf16x8 pa0,bf16x8 pa1,bf16x8 pa2,bf16x8 pa3){
  #pragma unroll
  for(int d0=0;d0<2;++d0){s16x4 lo[4],hi[4];
    #pragma unroll
    for(int ks=0;ks<4;++ks){
      asm volatile("ds_read_b64_tr_b16 %0,%1 offset:%c2":"=&v"(lo[ks]):"v"(vb),"i"(d0*4096+ks*1024):"memory");
      asm volatile("ds_read_b64_tr_b16 %0,%1 offset:%c2":"=&v"(hi[ks]):"v"(vb),"i"(d0*4096+ks*1024+512):"memory");}
    asm volatile("s_waitcnt lgkmcnt(0)":::"memory");SBAR();
    #define PK(k) (bf16x8){lo[k][0],lo[k][1],lo[k][2],lo[k][3],hi[k][0],hi[k][1],hi[k][2],hi[k][3]}
    o[d0]=__builtin_amdgcn_mfma_f32_32x32x16_bf16(pa0,PK(0),o[d0],0,0,0);
    o[d0]=__builtin_amdgcn_mfma_f32_32x32x16_bf16(pa1,PK(1),o[d0],0,0,0);
    o[d0]=__builtin_amdgcn_mfma_f32_32x32x16_bf16(pa2,PK(2),o[d0],0,0,0);
    o[d0]=__builtin_amdgcn_mfma_f32_32x32x16_bf16(pa3,PK(3),o[d0],0,0,0);
    #undef PK
  }
}

#ifndef ATTN_STORE16
#define ATTN_STORE16(p,v) (*(u32x4*)(p)=(v))
#endif
template<int THRL,bool FIXEDM=false> __device__ __forceinline__ void attn_unit(const bf16*Qu,const bf16*__restrict__ Kh,const bf16*__restrict__ Vh,bf16*Ou,const int DM,const int OP,const int NT,char*shm,const float kmaxs=0.f){
  int tid=threadIdx.x; asm volatile("":"+v"(tid));
  const int lane=tid&63,r32=lane&31,hi=lane>>5; const int wid=__builtin_amdgcn_readfirstlane(tid>>6);
  const bf16*Qw=Qu+(long)(wid*QBLK)*DM;
  const unsigned lds0=(unsigned)(uintptr_t)shm;
  float*wsf=(float*)(shm+LDS_WS)+wid*64;
  const bf16*ksrc=Kh+(long)lane*DM+wid*8;
  const bf16*vsrc=Vh+(long)(16*(wid&3)+(lane>>2))*DM+(wid>>2)*32+(lane&3)*8;
  const unsigned kdst=lds0+LDS_K+wid*1024, vdst=lds0+LDS_V+wid*1024;
  #define DMA_K(t,slot) glds16(ksrc+(long)(t)*KVBLK*DM,(unsigned)__builtin_amdgcn_readfirstlane(kdst+(slot)))
  #define DMA_V(t,slot) glds16(vsrc+(long)(t)*KVBLK*DM,(unsigned)__builtin_amdgcn_readfirstlane(vdst+(slot)))
  const int vb0=(int)(lds0+LDS_V)+((lane>>4)&1)*32+(lane&3)*8+(4*hi+((lane&15)>>2))*64;
  const char*Kbase=shm+LDS_K; bf16x8 kf[8];
  const lds_cptr shm3=(lds_cptr)shm; const lds_cptr kp0=shm3+LDS_K+hi*1024+r32*16; const lds_cptr vp0=shm3+LDS_V+((lane>>4)&1)*32+(lane&3)*8+(4*hi+((lane&15)>>2))*64;
  if(wid>=4)__builtin_amdgcn_s_setprio(1);
  DMA_K(0,0);DMA_V(0,0);DMA_K(1,SLOTB);
  bf16x8 qr[4];
  #pragma unroll
  for(int d0=0;d0<4;++d0)qr[d0]=*reinterpret_cast<const bf16x8*>(&Qw[(long)r32*DM+d0*16+hi*8]);
  float mb=0.f;
  if constexpr(FIXEDM){ float q2=0.f;
    _Pragma("unroll") for(int d0=0;d0<4;++d0){ const u32x4 w_=__builtin_bit_cast(u32x4,qr[d0]);
      _Pragma("unroll") for(int e=0;e<4;++e){ const float lo_=__uint_as_float(w_[e]<<16),hi_=__uint_as_float(w_[e]&0xffff0000u); q2+=lo_*lo_+hi_*hi_; } }
    { auto rr=__builtin_amdgcn_permlane32_swap(__float_as_uint(q2),__float_as_uint(q2),false,false); q2=__uint_as_float(rr[0])+__uint_as_float(rr[1]); }
    mb=__builtin_sqrtf(q2)*kmaxs; }
  float mhat=0.f,l_reg=0.f;f32x16 o[2];o[0]=f32x16{};o[1]=f32x16{};f32x16 negm=f32x16{};asm volatile("":"+v"(negm));
  #define CMASK(P0,P1,t) do{}while(0)
  bool resc=false;
  #define START(P0,P1) do{ const float rm=FIXEDM?mb:rowmax(P0,P1); resc=false; \
    { const float dl=rm; mhat=fadd_s(mhat,dl); \
      _Pragma("unroll") for(int r=0;r<16;++r){P0[r]=fsub_s(P0[r],dl);P1[r]=fsub_s(P1[r],dl);} \
      _Pragma("unroll") for(int r=0;r<16;++r)negm[r]=-mhat; asm volatile("":"+v"(negm)); } \
    _Pragma("unroll") for(int r=0;r<16;++r)P0[r]=__builtin_amdgcn_exp2f(P0[r]); }while(0)
  #define RESC() do{ if(resc){ asm volatile("s_waitcnt lgkmcnt(0)":::"memory"); \
      _Pragma("unroll") for(int d_=0;d_<2;++d_) _Pragma("unroll") for(int r=0;r<16;++r)o[d_][r]*=wsf[crow(r,hi)]; } }while(0)
  f32x16 pA0,pA1,pB0,pB1;
  int sl_prev=0,sl_cur=0,sl_next=SLOTB;
  #define ROT() do{sl_prev=sl_cur;sl_cur=sl_next;sl_next=(sl_next==(NSLOT-1)*SLOTB)?0:sl_next+SLOTB;}while(0)
  DMA_K(2,2*SLOTB);
  WAIT_BAR(3);
  qkt(pA0,pA1,Kbase,qr,negm,r32,hi);asm volatile("s_nop 15\n\ts_nop 7":"+v"(pA0),"+v"(pA1));CMASK(pA0,pA1,0);
  START(pA0,pA1);
  _Pragma("unroll") for(int r=0;r<16;++r)pA1[r]=__builtin_amdgcn_exp2f(pA1[r]);
  WAIT_BAR(0);
  DMA_K(3,0);DMA_V(1,SLOTB);
  ROT();
  kload8(kf,kp0+sl_cur);
  WAIT_BAR(2);
  s16x4 vlo[8],vhi[8]; u32x4 pw0,pw1,pw2,pw3;
  #define PKW(P,B) cvtpk_s(P[B],P[B+1])
  #define PAF(k) __builtin_bit_cast(bf16x8,pw##k)
  #define VFR(i) (bf16x8){vlo[i][0],vlo[i][1],vlo[i][2],vlo[i][3],vhi[i][0],vhi[i][1],vhi[i][2],vhi[i][3]}
  #define PIN(x) asm volatile("":"+v"(x))
  #define MX3(a,b,c) __builtin_fmaxf(__builtin_fmaxf((a),(b)),(c))
  #define GAPA(MF,A0,A1,A2,A3,W0,W1,PW) do{ MF; sacc+=A0; sacc+=A1; sacc+=A2; sacc+=A3; PIN(sacc); W0; W1; PIN(PW); SBAR(); }while(0)
  #define EX(v) __builtin_amdgcn_exp2f(v)
  #define GAPB(MF,X,B) do{ MF; X[B]=EX(X[B]); X[B+1]=EX(X[B+1]); X[B+2]=EX(X[B+2]); X[B+3]=EX(X[B+3]); PIN(X); SBAR(); }while(0)
  #define VRD(i) do{ vlo[i]=vtr(vp_+(((i)>>2)*4096+((i)&3)*1024)); vhi[i]=vtr(vp_+(((i)>>2)*4096+((i)&3)*1024+512)); }while(0)
  #define KRD(G,j) do{ if(G){ kload2(kf,kp0+sl_next,j); SBAR(); } }while(0)
  #define STEP(C0,C1,P0,P1,t,GK,GV,GL) do{ SBAR(); \
    const lds_cptr vp_=vp0+sl_prev; \
    VRD(0); SBAR(); float sacc=(P0[0]+P0[1]); \
    GAPA(C0=__builtin_amdgcn_mfma_f32_32x32x16_bf16(kf[0],qr[0],negm,0,0,0), P0[2],P0[3],P0[4],P0[5],     pw0[0]=PKW(P0,0), pw0[1]=PKW(P0,2), pw0); \
    VRD(4); SBAR(); GAPA(C1=__builtin_amdgcn_mfma_f32_32x32x16_bf16(kf[1],qr[0],negm,0,0,0), P0[6],P0[7],P0[8],P0[9],     pw0[2]=PKW(P0,4), pw0[3]=PKW(P0,6), pw0); \
    VRD(1); SBAR(); GAPA(C0=__builtin_amdgcn_mfma_f32_32x32x16_bf16(kf[2],qr[1],C0,0,0,0),   P0[10],P0[11],P0[12],P0[13], pw1[0]=PKW(P0,8), pw1[1]=PKW(P0,10), pw1); \
    VRD(5); SBAR(); GAPA(C1=__builtin_amdgcn_mfma_f32_32x32x16_bf16(kf[3],qr[1],C1,0,0,0),   P0[14],P0[15],P1[0],P1[1],   pw1[2]=PKW(P0,12),pw1[3]=PKW(P0,14), pw1); \
    VRD(2); SBAR(); GAPA(C0=__builtin_amdgcn_mfma_f32_32x32x16_bf16(kf[4],qr[2],C0,0,0,0),   P1[2],P1[3],P1[4],P1[5],     pw2[0]=PKW(P1,0), pw2[1]=PKW(P1,2), pw2); \
    VRD(6); SBAR(); GAPA(C1=__builtin_amdgcn_mfma_f32_32x32x16_bf16(kf[5],qr[2],C1,0,0,0),   P1[6],P1[7],P1[8],P1[9],     pw2[2]=PKW(P1,4), pw2[3]=PKW(P1,6), pw2); \
    VRD(3); SBAR(); GAPA(C0=__builtin_amdgcn_mfma_f32_32x32x16_bf16(kf[6],qr[3],C0,0,0,0),   P1[10],P1[11],P1[12],P1[13], pw3[0]=PKW(P1,8), pw3[1]=PKW(P1,10), pw3); \
    VRD(7); SBAR(); GAPA(C1=__builtin_amdgcn_mfma_f32_32x32x16_bf16(kf[7],qr[3],C1,0,0,0),   P1[14],P1[15],0.f,0.f,       pw3[2]=PKW(P1,12),pw3[3]=PKW(P1,14), pw3); \
    l_reg+=sacc; \
    if(GK){DMA_K((t)+3,sl_cur);} if(GV){DMA_V((t)+1,sl_next);} \
    CMASK(C0,C1,t); \
    if constexpr(!FIXEDM){ float a=MX3(C0[0],C0[1],C1[0]),b=MX3(C0[2],C0[3],C1[1]); a=MX3(a,C1[2],C1[3]); \
      _Pragma("unroll") for(int r=4;r<16;r+=4){a=MX3(a,C0[r],C0[r+1]);b=MX3(b,C0[r+2],C0[r+3]);a=MX3(a,C1[r],C1[r+1]);b=MX3(b,C1[r+2],C1[r+3]);} \
      float rm=__builtin_fmaxf(a,b); { auto rr=__builtin_amdgcn_permlane32_swap(__float_as_uint(rm),__float_as_uint(rm),false,false); rm=__builtin_fmaxf(__uint_as_float(rr[0]),__uint_as_float(rr[1])); } \
      resc=false; \
      if(__builtin_expect(__any(rm>(float)THRL),0)){ const float dl=__builtin_fmaxf(rm,0.f); mhat+=dl; \
        _Pragma("unroll") for(int r=0;r<16;++r){C0[r]-=dl;C1[r]-=dl;} \
        _Pragma("unroll") for(int r=0;r<16;++r)negm[r]=-mhat; asm volatile("":"+v"(negm)); \
        const float f=__builtin_amdgcn_exp2f(-dl); l_reg*=f; if(hi==0)wsf[r32]=f; resc=true; } } \
    SBAR(); \
    GAPB(o[0]=__builtin_amdgcn_mfma_f32_32x32x16_bf16(PAF(0),VFR(0),o[0],0,0,0), C0,0); \
    GAPB(o[1]=__builtin_amdgcn_mfma_f32_32x32x16_bf16(PAF(0),VFR(4),o[1],0,0,0), C0,4); \
    KRD(GL,0); GAPB(o[0]=__builtin_amdgcn_mfma_f32_32x32x16_bf16(PAF(1),VFR(1),o[0],0,0,0), C0,8); \
    KRD(GL,1); GAPB(o[1]=__builtin_amdgcn_mfma_f32_32x32x16_bf16(PAF(1),VFR(5),o[1],0,0,0), C0,12); \
    KRD(GL,2); GAPB(o[0]=__builtin_amdgcn_mfma_f32_32x32x16_bf16(PAF(2),VFR(2),o[0],0,0,0), C1,0); \
    KRD(GL,3); GAPB(o[1]=__builtin_amdgcn_mfma_f32_32x32x16_bf16(PAF(2),VFR(6),o[1],0,0,0), C1,4); \
    GAPB(o[0]=__builtin_amdgcn_mfma_f32_32x32x16_bf16(PAF(3),VFR(3),o[0],0,0,0), C1,8); \
    GAPB(o[1]=__builtin_amdgcn_mfma_f32_32x32x16_bf16(PAF(3),VFR(7),o[1],0,0,0), C1,12); \
    }while(0)
  int t=1;
  for(;t+5<NT;t+=2){
    STEP(pB0,pB1,pA0,pA1,t,true,true,true);     WAIT_BAR(2); RESC(); ROT();
    STEP(pA0,pA1,pB0,pB1,t+1,true,true,true);   WAIT_BAR(2); RESC(); ROT();
  }
  #define ENDW(tt) do{ if((tt)+3<NT){WAIT_BAR(2);} else if((tt)+2<NT){WAIT_BAR(1);} else {WAIT_BAR(0);} }while(0)
  for(;t+1<NT;t+=2){
    STEP(pB0,pB1,pA0,pA1,t,(t+3<NT),(t+1<NT),(t+1<NT));       ENDW(t);   RESC(); ROT();
    STEP(pA0,pA1,pB0,pB1,t+1,(t+4<NT),(t+2<NT),(t+2<NT));     ENDW(t+1); RESC(); ROT();
  }
  STEP(pB0,pB1,pA0,pA1,NT-1,false,false,false); RESC();
  { float sacc=pB0[0]+pB0[1]; _Pragma("unroll") for(int r=2;r<16;++r)sacc+=pB0[r]; _Pragma("unroll") for(int r=0;r<16;++r)sacc+=pB1[r]; l_reg+=sacc;
    pw0=(u32x4){PKW(pB0,0),PKW(pB0,2),PKW(pB0,4),PKW(pB0,6)};pw1=(u32x4){PKW(pB0,8),PKW(pB0,10),PKW(pB0,12),PKW(pB0,14)};pw2=(u32x4){PKW(pB1,0),PKW(pB1,2),PKW(pB1,4),PKW(pB1,6)};pw3=(u32x4){PKW(pB1,8),PKW(pB1,10),PKW(pB1,12),PKW(pB1,14)};
    SBAR(); pv(o,vb0+sl_cur,PAF(0),PAF(1),PAF(2),PAF(3)); }
  #undef PKW
  #undef PAF
  #undef VFR
  #undef PIN
  #undef MX3
  #undef GAPA
  #undef GAPB
  #undef EX
  #undef VRD
  #undef KRD
  #undef STEP
  #undef ENDW
  {auto rr=__builtin_amdgcn_permlane32_swap(__float_as_uint(l_reg),__float_as_uint(l_reg),false,false);l_reg=__uint_as_float(rr[0])+__uint_as_float(rr[1]);}
  if(hi==0)wsf[32+r32]=l_reg;asm volatile("s_waitcnt lgkmcnt(0)":::"memory");
  float rli[16];
  #pragma unroll
  for(int r=0;r<16;++r)rli[r]=__builtin_amdgcn_rcpf(wsf[32+crow(r,hi)]);
  bf16*Ow=Ou+(long)(wid*QBLK)*OP;
  { bf16*stg=(bf16*)(shm+LDS_OST)+wid*2048;
    #pragma unroll
    for(int r=0;r<16;++r){const int orow=crow(r,hi);
      #pragma unroll
      for(int d0=0;d0<2;++d0)stg[orow*64+d0*32+r32]=__float2bfloat16(o[d0][r]*rli[r]);}
    asm volatile("s_waitcnt lgkmcnt(0)":::"memory");
    #pragma unroll
    for(int i=0;i<4;++i){const int row=i*8+(lane>>3),ch=lane&7; const u32x4 v=*(const u32x4*)(stg+row*64+ch*8); ATTN_STORE16(Ow+(long)row*OP+ch*8,v);} }
  asm volatile("s_waitcnt lgkmcnt(0)\n\ts_barrier":::"memory");
  if(wid>=4)__builtin_amdgcn_s_setprio(0);
  #undef DMA_K
  #undef DMA_V
  #undef CMASK
  #undef START
  #undef RESC
  #undef ROT
}
constexpr int ATTN_LDS_BYTES=LDS_BYTES;
}

namespace attn128 {
using bf16=__hip_bfloat16;
using bf16x8=__attribute__((ext_vector_type(8)))short;
using s16x4=__attribute__((ext_vector_type(4)))short;
using f32x16=__attribute__((ext_vector_type(16)))float;
using u32x4=__attribute__((ext_vector_type(4)))unsigned;
constexpr int D=64;
constexpr int NW=8,QBLK=32,QB=QBLK*NW,KVBLK=64;
__device__ __forceinline__ int crow(int r,int hi){return (r&3)+8*(r>>2)+4*hi;}
#define SBAR() __builtin_amdgcn_sched_barrier(0)
constexpr int NSLOT=3, SLOTB=8192;
constexpr int KSLOTS=4, LDS_K=0, LDS_V=KSLOTS*SLOTB, LDS_WS=LDS_V+2*NSLOT*SLOTB, LDS_OST=LDS_WS+NW*64*4, LDS_BYTES=LDS_OST+NW*8192;
constexpr float C2=0.125f*1.4426950408889634f;
__device__ __forceinline__ void glds16(const void*gsrc,unsigned lds_dst){unsigned keep;
  asm volatile("s_mov_b32 %0, m0\n\ts_mov_b32 m0, %2\n\ts_nop 0\n\tglobal_load_lds_dwordx4 %1, off\n\ts_mov_b32 m0, %0":"=&s"(keep):"v"(gsrc),"s"(lds_dst):"memory");}
__device__ __forceinline__ void glds16s(const void*gbase_,unsigned voff,unsigned lds_dst){unsigned keep;
  const unsigned long long gb_=(unsigned long long)(uintptr_t)gbase_; const unsigned long long gbase=((unsigned long long)(unsigned)__builtin_amdgcn_readfirstlane((int)(gb_>>32))<<32)|(unsigned)__builtin_amdgcn_readfirstlane((int)gb_);
  asm volatile("s_mov_b32 %0, m0\n\ts_mov_b32 m0, %3\n\ts_nop 0\n\tglobal_load_lds_dwordx4 %1, %2\n\ts_mov_b32 m0, %0":"=&s"(keep):"v"(voff),"s"(gbase),"s"(lds_dst):"memory");}
__device__ __forceinline__ float max3f(float a,float b,float c){float r;asm("v_max3_f32 %0, %1, %2, %3":"=v"(r):"v"(a),"v"(b),"v"(c));return r;}
__device__ __forceinline__ float max2f(float a,float b){float r;asm("v_max_f32_e32 %0, %1, %2":"=v"(r):"v"(a),"v"(b));return r;}
__device__ __forceinline__ float fadd_s(float a,float b){float r;asm("v_add_f32_e32 %0, %1, %2":"=v"(r):"v"(a),"v"(b));return r;}
__device__ __forceinline__ float fsub_s(float a,float b){float r;asm("v_sub_f32_e32 %0, %1, %2":"=v"(r):"v"(a),"v"(b));return r;}
typedef float f32x2_t __attribute__((ext_vector_type(2))); typedef __bf16 bf16x2_t __attribute__((ext_vector_type(2)));
__device__ __forceinline__ unsigned cvtpk_s(float lo,float hi){f32x2_t v={lo,hi};bf16x2_t b=__builtin_convertvector(v,bf16x2_t);return __builtin_bit_cast(unsigned,b);}
#define WAIT_BAR(N) asm volatile("s_waitcnt vmcnt(" #N ") lgkmcnt(0)\n\ts_barrier":::"memory")

__device__ __forceinline__ void qkt(f32x16&p0,f32x16&p1,const char*Kslot,const bf16x8*qr,const f32x16&negm,int r32,int hi){
  const char*kb=Kslot+hi*1024+r32*16;
  #pragma unroll
  for(int d0=0;d0<4;++d0){
    const bf16x8 b0=*reinterpret_cast<const bf16x8*>(kb+d0*2048);
    const bf16x8 b1=*reinterpret_cast<const bf16x8*>(kb+d0*2048+512);
    if(d0==0){p0=__builtin_amdgcn_mfma_f32_32x32x16_bf16(b0,qr[0],negm,0,0,0);p1=__builtin_amdgcn_mfma_f32_32x32x16_bf16(b1,qr[0],negm,0,0,0);}
    else{p0=__builtin_amdgcn_mfma_f32_32x32x16_bf16(b0,qr[d0],p0,0,0,0);p1=__builtin_amdgcn_mfma_f32_32x32x16_bf16(b1,qr[d0],p1,0,0,0);}}
}
typedef __attribute__((address_space(3))) const char* lds_cptr;
typedef short v4i16_t __attribute__((ext_vector_type(4)));
__device__ __forceinline__ void kload8(bf16x8*kf,lds_cptr kp){
  kf[0]=*(const __attribute__((address_space(3))) bf16x8*)(kp);      kf[1]=*(const __attribute__((address_space(3))) bf16x8*)(kp+512);
  kf[2]=*(const __attribute__((address_space(3))) bf16x8*)(kp+2048); kf[3]=*(const __attribute__((address_space(3))) bf16x8*)(kp+2560);
  kf[4]=*(const __attribute__((address_space(3))) bf16x8*)(kp+4096); kf[5]=*(const __attribute__((address_space(3))) bf16x8*)(kp+4608);
  kf[6]=*(const __attribute__((address_space(3))) bf16x8*)(kp+6144); kf[7]=*(const __attribute__((address_space(3))) bf16x8*)(kp+6656);
}
__device__ __forceinline__ void kload2(bf16x8*kf,lds_cptr kp,int j){ kf[2*j]=*(const __attribute__((address_space(3))) bf16x8*)(kp+j*2048); kf[2*j+1]=*(const __attribute__((address_space(3))) bf16x8*)(kp+j*2048+512); }
__device__ __forceinline__ s16x4 vtr(lds_cptr p){ return __builtin_bit_cast(s16x4,__builtin_amdgcn_ds_read_tr16_b64_v4i16((__attribute__((address_space(3))) v4i16_t*)p)); }
__device__ __forceinline__ float rowmax(const f32x16&p0,const f32x16&p1){
  float a=max3f(p0[0],p0[1],p1[0]),b=max3f(p0[2],p0[3],p1[1]);a=max3f(a,p1[2],p1[3]);
  #pragma unroll
  for(int r=4;r<16;r+=4){a=max3f(a,p0[r],p0[r+1]);b=max3f(b,p0[r+2],p0[r+3]);a=max3f(a,p1[r],p1[r+1]);b=max3f(b,p1[r+2],p1[r+3]);}
  const float m=max2f(a,b);
  auto rr=__builtin_amdgcn_permlane32_swap(__float_as_uint(m),__float_as_uint(m),false,false);
  return max2f(__uint_as_float(rr[0]),__uint_as_float(rr[1]));
}
__device__ __forceinline__ void pv(f32x16*o,int vb,bf16x8 pa0,bf16x8 pa1,bf16x8 pa2,bf16x8 pa3){
  #pragma unroll
  for(int d0=0;d0<4;++d0){s16x4 lo[4],hi[4];
    #pragma unroll
    for(int ks=0;ks<4;++ks){
      asm volatile("ds_read_b64_tr_b16 %0,%1 offset:%c2":"=&v"(lo[ks]):"v"(vb),"i"(d0*4096+ks*1024):"memory");
      asm volatile("ds_read_b64_tr_b16 %0,%1 offset:%c2":"=&v"(hi[ks]):"v"(vb),"i"(d0*4096+ks*1024+512):"memory");}
    asm volatile("s_waitcnt lgkmcnt(0)":::"memory");SBAR();
    #define PK(k) (bf16x8){lo[k][0],lo[k][1],lo[k][2],lo[k][3],hi[k][0],hi[k][1],hi[k][2],hi[k][3]}
    o[d0]=__builtin_amdgcn_mfma_f32_32x32x16_bf16(pa0,PK(0),o[d0],0,0,0);
    o[d0]=__builtin_amdgcn_mfma_f32_32x32x16_bf16(pa1,PK(1),o[d0],0,0,0);
    o[d0]=__builtin_amdgcn_mfma_f32_32x32x16_bf16(pa2,PK(2),o[d0],0,0,0);
    o[d0]=__builtin_amdgcn_mfma_f32_32x32x16_bf16(pa3,PK(3),o[d0],0,0,0);
    #undef PK
  }
}

#ifndef ATTN_STORE16
#define ATTN_STORE16(p,v) (*(u32x4*)(p)=(v))
#endif
template<int THRL,bool FIXEDM=false> __device__ __forceinline__ void attn_unit(const bf16*Qu,const bf16*__restrict__ Kh,const bf16*__restrict__ Vh,bf16*Ou,const int DM,const int OP,const int NT,char*shm,const float kmaxs=0.f){
  int tid=threadIdx.x; asm volatile("":"+v"(tid));
  const int lane=tid&63,r32=lane&31,hi=lane>>5; const int wid=__builtin_amdgcn_readfirstlane(tid>>6);
  const bf16*Qw=Qu+(long)(wid*QBLK)*DM;
  const unsigned lds0=(unsigned)(uintptr_t)shm;
  float*wsf=(float*)(shm+LDS_WS)+wid*64;
  const unsigned koff=(unsigned)(lane*DM+wid*8)*2u;
  const unsigned voff0=(unsigned)((16*((2*wid)&3)+(lane>>2))*DM+((2*wid)>>2)*32+(lane&3)*8)*2u;
  const unsigned voff1=(unsigned)((16*((2*wid+1)&3)+(lane>>2))*DM+((2*wid+1)>>2)*32+(lane&3)*8)*2u;
  const unsigned kdst=lds0+LDS_K+wid*1024, vdst=lds0+LDS_V+wid*2048;
  #define DMA_K(t,slot) glds16s(Kh+(long)(t)*KVBLK*DM,koff,(unsigned)__builtin_amdgcn_readfirstlane(kdst+(slot)))
  #define DMA_V(t,slot) do{ glds16s(Vh+(long)(t)*KVBLK*DM,voff0,(unsigned)__builtin_amdgcn_readfirstlane(vdst+2*(slot))); glds16s(Vh+(long)(t)*KVBLK*DM,voff1,(unsigned)__builtin_amdgcn_readfirstlane(vdst+1024+2*(slot))); }while(0)
  const char*Kbase=shm+LDS_K;
  #define KLD(ko,i) (*(const __attribute__((address_space(3))) bf16x8*)(kp0+(ko)+((i)>>1)*2048+((i)&1)*512))
  const lds_cptr shm3=(lds_cptr)shm; const lds_cptr kp0=shm3+LDS_K+hi*1024+r32*16; const lds_cptr vp0=shm3+LDS_V+((lane>>4)&1)*32+(lane&3)*8+(4*hi+((lane&15)>>2))*64;
  if(wid>=4)__builtin_amdgcn_s_setprio(1);
  DMA_K(0,0);DMA_V(0,0);DMA_K(1,SLOTB);
  bf16x8 qr[4];
  #pragma unroll
  for(int d0=0;d0<4;++d0)qr[d0]=*reinterpret_cast<const bf16x8*>(&Qw[(long)r32*DM+d0*16+hi*8]);
  float mb=0.f;
  if constexpr(FIXEDM){ float q2=0.f;
    _Pragma("unroll") for(int d0=0;d0<4;++d0){ const u32x4 w_=__builtin_bit_cast(u32x4,qr[d0]);
      _Pragma("unroll") for(int e=0;e<4;++e){ const float lo_=__uint_as_float(w_[e]<<16),hi_=__uint_as_float(w_[e]&0xffff0000u); q2+=lo_*lo_+hi_*hi_; } }
    { auto rr=__builtin_amdgcn_permlane32_swap(__float_as_uint(q2),__float_as_uint(q2),false,false); q2=__uint_as_float(rr[0])+__uint_as_float(rr[1]); }
    mb=__builtin_sqrtf(q2)*kmaxs; }
  const __attribute__((address_space(3))) bf16x8* qlp=(const __attribute__((address_space(3))) bf16x8*)(shm3+LDS_OST+wid*8192+lane*16);
  #pragma unroll
  for(int d0=0;d0<4;++d0)*(__attribute__((address_space(3))) bf16x8*)(shm3+LDS_OST+wid*8192+lane*16+d0*1024)=qr[d0];
  float mhat=0.f,l_reg=0.f;f32x16 o[4];o[0]=f32x16{};o[1]=f32x16{};o[2]=f32x16{};o[3]=f32x16{};f32x16 negm=f32x16{};asm volatile("":"+v"(negm));
  #define CMASK(P0,P1,t) do{}while(0)
  bool resc=false;
  #define START(P0,P1) do{ const float rm=FIXEDM?mb:rowmax(P0,P1); resc=false; \
    { const float dl=rm; mhat=fadd_s(mhat,dl); \
      _Pragma("unroll") for(int r=0;r<16;++r){P0[r]=fsub_s(P0[r],dl);P1[r]=fsub_s(P1[r],dl);} \
      _Pragma("unroll") for(int r=0;r<16;++r)negm[r]=-mhat; asm volatile("":"+v"(negm)); } \
    _Pragma("unroll") for(int r=0;r<16;++r)P0[r]=__builtin_amdgcn_exp2f(P0[r]); }while(0)
  #define RESC() do{ if(resc){ asm volatile("s_waitcnt lgkmcnt(0)":::"memory"); \
      _Pragma("unroll") for(int d_=0;d_<4;++d_) _Pragma("unroll") for(int r=0;r<16;++r)o[d_][r]*=wsf[crow(r,hi)]; } }while(0)
  f32x16 c0,c1;
  u32x4 pwA0,pwA1,pwA2,pwA3,pwB0,pwB1,pwB2,pwB3;
  int sl_prev=0,sl_cur=0,sl_next=SLOTB;
  int kc=0;
  #define KNEXT(n) ((kc+(n)*SLOTB)&(KSLOTS*SLOTB-1))
  #define ROT() do{sl_prev=sl_cur;sl_cur=sl_next;sl_next=(sl_next==(NSLOT-1)*SLOTB)?0:sl_next+SLOTB;kc=KNEXT(1);}while(0)
  #define PKW(P,B) cvtpk_s(P[B],P[B+1])
  DMA_K(2,2*SLOTB);
  WAIT_BAR(4);
  qkt(c0,c1,Kbase,qr,negm,r32,hi);asm volatile("s_nop 15\n\ts_nop 7":"+v"(c0),"+v"(c1));
  START(c0,c1);
  _Pragma("unroll") for(int r=0;r<16;++r)c1[r]=__builtin_amdgcn_exp2f(c1[r]);
  { float sacc=c0[0]+c0[1]; _Pragma("unroll") for(int r=2;r<16;++r)sacc+=c0[r]; _Pragma("unroll") for(int r=0;r<16;++r)sacc+=c1[r]; l_reg+=sacc;
    pwA0=(u32x4){PKW(c0,0),PKW(c0,2),PKW(c0,4),PKW(c0,6)};pwA1=(u32x4){PKW(c0,8),PKW(c0,10),PKW(c0,12),PKW(c0,14)};pwA2=(u32x4){PKW(c1,0),PKW(c1,2),PKW(c1,4),PKW(c1,6)};pwA3=(u32x4){PKW(c1,8),PKW(c1,10),PKW(c1,12),PKW(c1,14)}; }
  WAIT_BAR(0);
  DMA_K(3,3*SLOTB);DMA_V(1,SLOTB);
  ROT();
  bf16x8 ka0=KLD(kc,0),ka1=KLD(kc,1);
  WAIT_BAR(3);
  s16x4 vlo[4],vhi[4]; bf16x8 q0_=qr[0],q1_=qr[1];
  #define PAF(S,k) __builtin_bit_cast(bf16x8,pw##S##k)
  #define VFR(i) (bf16x8){vlo[i][0],vlo[i][1],vlo[i][2],vlo[i][3],vhi[i][0],vhi[i][1],vhi[i][2],vhi[i][3]}
  #define PIN(x) asm volatile("":"+v"(x))
  #define MX3(a,b,c) __builtin_fmaxf(__builtin_fmaxf((a),(b)),(c))
  #define EX(v) __builtin_amdgcn_exp2f(v)
  #define GAPA(MF) do{ MF; SBAR(); }while(0)
  #define GAPB(MF,X,B,PWV,WI,RL) do{ MF; X[B]=EX(X[B]); X[B+1]=EX(X[B+1]); sacc+=X[B]; sacc+=X[B+1]; PWV[WI]=PKW(X,B); PIN(PWV); PIN(sacc); RL; SBAR(); }while(0)
  #define VRD(s,d,ks) do{ vlo[s]=vtr(vp_+((d)*4096+(ks)*1024)); vhi[s]=vtr(vp_+((d)*4096+(ks)*1024+512)); }while(0)
  #define KRD(G,j) do{ if(G){ kload2(kf,kp0+sl_next,j); SBAR(); } }while(0)
  #define NOP_() do{}while(0)
  #define MF32(a,b,c) __builtin_amdgcn_mfma_f32_32x32x16_bf16(a,b,c,0,0,0)
  #define STEP(N,O,t,GK,GV,GL) do{ SBAR(); \
    const lds_cptr vp_=vp0+2*sl_prev; \
    const bf16x8 kb2=KLD(kc,2),kb3=KLD(kc,3); const bf16x8 q2_=qlp[128]; SBAR(); GAPA(c0=MF32(ka0,q0_,negm)); \
    const bf16x8 q3_=qlp[192]; SBAR(); GAPA(c1=MF32(ka1,q0_,negm)); \
    const bf16x8 kb4=KLD(kc,4),kb5=KLD(kc,5); SBAR(); GAPA(c0=MF32(kb2,q1_,c0)); \
    GAPA(c1=MF32(kb3,q1_,c1)); \
    const bf16x8 kb6=KLD(kc,6),kb7=KLD(kc,7); VRD(0,0,0); SBAR(); GAPA(c0=MF32(kb4,q2_,c0)); \
    VRD(1,1,0); SBAR(); GAPA(c1=MF32(kb5,q2_,c1)); \
    VRD(2,2,0); SBAR(); GAPA(c0=MF32(kb6,q3_,c0)); \
    VRD(3,3,0); SBAR(); GAPA(c1=MF32(kb7,q3_,c1)); \
    if(GK){DMA_K((t)+3,KNEXT(3));} if(GV){DMA_V((t)+1,sl_next);} \
    if constexpr(!FIXEDM){ float a=MX3(c0[0],c0[1],c1[0]),b=MX3(c0[2],c0[3],c1[1]); a=MX3(a,c1[2],c1[3]); \
      _Pragma("unroll") for(int r=4;r<16;r+=4){a=MX3(a,c0[r],c0[r+1]);b=MX3(b,c0[r+2],c0[r+3]);a=MX3(a,c1[r],c1[r+1]);b=MX3(b,c1[r+2],c1[r+3]);} \
      float rm=__builtin_fmaxf(a,b); { auto rr=__builtin_amdgcn_permlane32_swap(__float_as_uint(rm),__float_as_uint(rm),false,false); rm=__builtin_fmaxf(__uint_as_float(rr[0]),__uint_as_float(rr[1])); } \
      resc=false; \
      if(__builtin_expect(__any(rm>(float)THRL),0)){ const float dl=__builtin_fmaxf(rm,0.f); mhat+=dl; \
        _Pragma("unroll") for(int r=0;r<16;++r){c0[r]-=dl;c1[r]-=dl;} \
        _Pragma("unroll") for(int r=0;r<16;++r)negm[r]=-mhat; asm volatile("":"+v"(negm)); \
        const float f=__builtin_amdgcn_exp2f(-dl); l_reg*=f; if(hi==0)wsf[r32]=f; resc=true; } } \
    SBAR(); float sacc=0.f; \
    GAPB(o[0]=MF32(PAF(O,0),VFR(0),o[0]), c0,0,  pw##N##0,0, VRD(0,0,1)); \
    GAPB(o[1]=MF32(PAF(O,0),VFR(1),o[1]), c0,2,  pw##N##0,1, VRD(1,1,1)); \
    GAPB(o[2]=MF32(PAF(O,0),VFR(2),o[2]), c0,4,  pw##N##0,2, VRD(2,2,1)); \
    GAPB(o[3]=MF32(PAF(O,0),VFR(3),o[3]), c0,6,  pw##N##0,3, VRD(3,3,1)); \
    GAPB(o[0]=MF32(PAF(O,1),VFR(0),o[0]), c0,8,  pw##N##1,0, VRD(0,0,2)); \
    GAPB(o[1]=MF32(PAF(O,1),VFR(1),o[1]), c0,10, pw##N##1,1, VRD(1,1,2)); \
    GAPB(o[2]=MF32(PAF(O,1),VFR(2),o[2]), c0,12, pw##N##1,2, VRD(2,2,2)); \
    GAPB(o[3]=MF32(PAF(O,1),VFR(3),o[3]), c0,14, pw##N##1,3, VRD(3,3,2)); \
    GAPB(o[0]=MF32(PAF(O,2),VFR(0),o[0]), c1,0,  pw##N##2,0, VRD(0,0,3)); \
    GAPB(o[1]=MF32(PAF(O,2),VFR(1),o[1]), c1,2,  pw##N##2,1, VRD(1,1,3)); \
    GAPB(o[2]=MF32(PAF(O,2),VFR(2),o[2]), c1,4,  pw##N##2,2, VRD(2,2,3)); \
    GAPB(o[3]=MF32(PAF(O,2),VFR(3),o[3]), c1,6,  pw##N##2,3, VRD(3,3,3)); \
    GAPB(o[0]=MF32(PAF(O,3),VFR(0),o[0]), c1,8,  pw##N##3,0, ka0=KLD(KNEXT(1),0)); \
    GAPB(o[1]=MF32(PAF(O,3),VFR(1),o[1]), c1,10, pw##N##3,1, ka1=KLD(KNEXT(1),1)); \
    GAPB(o[2]=MF32(PAF(O,3),VFR(2),o[2]), c1,12, pw##N##3,2, q0_=qlp[0]); \
    GAPB(o[3]=MF32(PAF(O,3),VFR(3),o[3]), c1,14, pw##N##3,3, q1_=qlp[64]); \
    l_reg+=sacc; \
    }while(0)
  int t=1;
  for(;t+5<NT;t+=2){
    STEP(B,A,t,true,true,true);     WAIT_BAR(3); RESC(); ROT();
    STEP(A,B,t+1,true,true,true);   WAIT_BAR(3); RESC(); ROT();
  }
  #define ENDW(tt) do{ if((tt)+3<NT){WAIT_BAR(3);} else if((tt)+2<NT){WAIT_BAR(2);} else {WAIT_BAR(0);} }while(0)
  for(;t+1<NT;t+=2){
    STEP(B,A,t,(t+3<NT),(t+1<NT),(t+1<NT));       ENDW(t);   RESC(); ROT();
    STEP(A,B,t+1,(t+4<NT),(t+2<NT),(t+2<NT));     ENDW(t+1); RESC(); ROT();
  }
  STEP(B,A,NT-1,false,false,false); RESC();
  { SBAR(); const int vb0=(int)(lds0+LDS_V)+((lane>>4)&1)*32+(lane&3)*8+(4*hi+((lane&15)>>2))*64; pv(o,vb0+2*sl_cur,PAF(B,0),PAF(B,1),PAF(B,2),PAF(B,3)); }
  #undef PKW
  #undef PAF
  #undef VFR
  #undef PIN
  #undef MX3
  #undef GAPA
  #undef GAPB
  #undef EX
  #undef VRD
  #undef KRD
  #undef STEP
  #undef KLD
  #undef KNEXT
  #undef NOP_
  #undef MF32
  #undef ENDW
  {auto rr=__builtin_amdgcn_permlane32_swap(__float_as_uint(l_reg),__float_as_uint(l_reg),false,false);l_reg=__uint_as_float(rr[0])+__uint_as_float(rr[1]);}
  if(hi==0)wsf[32+r32]=l_reg;asm volatile("s_waitcnt lgkmcnt(0)":::"memory");
  float rli[16];
  #pragma unroll
  for(int r=0;r<16;++r)rli[r]=__builtin_amdgcn_rcpf(wsf[32+crow(r,hi)]);
  bf16*Ow=Ou+(long)(wid*QBLK)*OP;
  { bf16*stg=(bf16*)(shm+LDS_OST)+wid*4096;
    #pragma unroll
    for(int r=0;r<16;++r){const int orow=crow(r,hi);
      #pragma unroll
      for(int d0=0;d0<4;++d0)stg[orow*128+d0*32+r32]=__float2bfloat16(o[d0][r]*rli[r]);}
    asm volatile("s_waitcnt lgkmcnt(0)":::"memory");
    #pragma unroll
    for(int i=0;i<8;++i){const int row=i*4+(lane>>4),ch=lane&15; const u32x4 v=*(const u32x4*)(stg+row*128+ch*8); ATTN_STORE16(Ow+(long)row*OP+ch*8,v);} }
  asm volatile("s_waitcnt lgkmcnt(0)\n\ts_barrier":::"memory");
  if(wid>=4)__builtin_amdgcn_s_setprio(0);
  #undef DMA_K
  #undef DMA_V
  #undef CMASK
  #undef START
  #undef RESC
  #undef ROT
}
constexpr int ATTN_LDS_BYTES=LDS_BYTES;
}

namespace attn_msk {
using bf16=__hip_bfloat16;
using bf16x8=__attribute__((ext_vector_type(8)))short;
using s16x4=__attribute__((ext_vector_type(4)))short;
using f32x16=__attribute__((ext_vector_type(16)))float;
using u32x4=__attribute__((ext_vector_type(4)))unsigned;
constexpr int D=64;
constexpr int NW=8,QBLK=32,QB=QBLK*NW,KVBLK=64;
__device__ __forceinline__ int crow(int r,int hi){return (r&3)+8*(r>>2)+4*hi;}
#define SBAR() __builtin_amdgcn_sched_barrier(0)
constexpr int NSLOT=3, SLOTB=8192;
constexpr int KSLOTS=4, LDS_K=0, LDS_V=KSLOTS*SLOTB, LDS_WS=LDS_V+NSLOT*SLOTB, LDS_OST=LDS_WS+NW*64*4, LDS_BYTES=LDS_OST+NW*4096;
constexpr float C2=0.125f*1.4426950408889634f;
__device__ __forceinline__ void glds16(const void*gsrc,unsigned lds_dst){unsigned keep;
  asm volatile("s_mov_b32 %0, m0\n\ts_mov_b32 m0, %2\n\ts_nop 0\n\tglobal_load_lds_dwordx4 %1, off\n\ts_mov_b32 m0, %0":"=&s"(keep):"v"(gsrc),"s"(lds_dst):"memory");}
__device__ __forceinline__ void glds16s(const void*gbase,unsigned voff,unsigned lds_dst){unsigned keep;
  asm volatile("s_mov_b32 %0, m0\n\ts_mov_b32 m0, %3\n\ts_nop 0\n\tglobal_load_lds_dwordx4 %1, %2\n\ts_mov_b32 m0, %0":"=&s"(keep):"v"(voff),"s"(gbase),"s"(lds_dst):"memory");}
__device__ __forceinline__ float max3f(float a,float b,float c){float r;asm("v_max3_f32 %0, %1, %2, %3":"=v"(r):"v"(a),"v"(b),"v"(c));return r;}
__device__ __forceinline__ float max2f(float a,float b){float r;asm("v_max_f32_e32 %0, %1, %2":"=v"(r):"v"(a),"v"(b));return r;}
__device__ __forceinline__ float fadd_s(float a,float b){float r;asm("v_add_f32_e32 %0, %1, %2":"=v"(r):"v"(a),"v"(b));return r;}
__device__ __forceinline__ float fsub_s(float a,float b){float r;asm("v_sub_f32_e32 %0, %1, %2":"=v"(r):"v"(a),"v"(b));return r;}
typedef float f32x2_t __attribute__((ext_vector_type(2))); typedef __bf16 bf16x2_t __attribute__((ext_vector_type(2)));
__device__ __forceinline__ unsigned cvtpk_s(float lo,float hi){f32x2_t v={lo,hi};bf16x2_t b=__builtin_convertvector(v,bf16x2_t);return __builtin_bit_cast(unsigned,b);}
#define WAIT_BAR(N) asm volatile("s_waitcnt vmcnt(" #N ") lgkmcnt(0)\n\ts_barrier":::"memory")

__device__ __forceinline__ void qkt(f32x16&p0,f32x16&p1,const char*Kslot,const bf16x8*qr,const f32x16&negm,int r32,int hi){
  const char*kb=Kslot+hi*1024+r32*16;
  #pragma unroll
  for(int d0=0;d0<4;++d0){
    const bf16x8 b0=*reinterpret_cast<const bf16x8*>(kb+d0*2048);
    const bf16x8 b1=*reinterpret_cast<const bf16x8*>(kb+d0*2048+512);
    if(d0==0){p0=__builtin_amdgcn_mfma_f32_32x32x16_bf16(b0,qr[0],negm,0,0,0);p1=__builtin_amdgcn_mfma_f32_32x32x16_bf16(b1,qr[0],negm,0,0,0);}
    else{p0=__builtin_amdgcn_mfma_f32_32x32x16_bf16(b0,qr[d0],p0,0,0,0);p1=__builtin_amdgcn_mfma_f32_32x32x16_bf16(b1,qr[d0],p1,0,0,0);}}
}
typedef __attribute__((address_space(3))) const char* lds_cptr;
typedef short v4i16_t __attribute__((ext_vector_type(4)));
__device__ __forceinline__ void kload8(bf16x8*kf,lds_cptr kp){
  kf[0]=*(const __attribute__((address_space(3))) bf16x8*)(kp);      kf[1]=*(const __attribute__((address_space(3))) bf16x8*)(kp+512);
  kf[2]=*(const __attribute__((address_space(3))) bf16x8*)(kp+2048); kf[3]=*(const __attribute__((address_space(3))) bf16x8*)(kp+2560);
  kf[4]=*(const __attribute__((address_space(3))) bf16x8*)(kp+4096); kf[5]=*(const __attribute__((address_space(3))) bf16x8*)(kp+4608);
  kf[6]=*(const __attribute__((address_space(3))) bf16x8*)(kp+6144); kf[7]=*(const __attribute__((address_space(3))) bf16x8*)(kp+6656);
}
__device__ __forceinline__ void kload2(bf16x8*kf,lds_cptr kp,int j){ kf[2*j]=*(const __attribute__((address_space(3))) bf16x8*)(kp+j*2048); kf[2*j+1]=*(const __attribute__((address_space(3))) bf16x8*)(kp+j*2048+512); }
__device__ __forceinline__ s16x4 vtr(lds_cptr p){ return __builtin_bit_cast(s16x4,__builtin_amdgcn_ds_read_tr16_b64_v4i16((__attribute__((address_space(3))) v4i16_t*)p)); }
__device__ __forceinline__ float rowmax(const f32x16&p0,const f32x16&p1){
  float a=max3f(p0[0],p0[1],p1[0]),b=max3f(p0[2],p0[3],p1[1]);a=max3f(a,p1[2],p1[3]);
  #pragma unroll
  for(int r=4;r<16;r+=4){a=max3f(a,p0[r],p0[r+1]);b=max3f(b,p0[r+2],p0[r+3]);a=max3f(a,p1[r],p1[r+1]);b=max3f(b,p1[r+2],p1[r+3]);}
  const float m=max2f(a,b);
  auto rr=__builtin_amdgcn_permlane32_swap(__float_as_uint(m),__float_as_uint(m),false,false);
  return max2f(__uint_as_float(rr[0]),__uint_as_float(rr[1]));
}
__device__ __forceinline__ void pv(f32x16*o,int vb,bf16x8 pa0,bf16x8 pa1,bf16x8 pa2,bf16x8 pa3){
  #pragma unroll
  for(int d0=0;d0<2;++d0){s16x4 lo[4],hi[4];
    #pragma unroll
    for(int ks=0;ks<4;++ks){
      asm volatile("ds_read_b64_tr_b16 %0,%1 offset:%c2":"=&v"(lo[ks]):"v"(vb),"i"(d0*4096+ks*1024):"memory");
      asm volatile("ds_read_b64_tr_b16 %0,%1 offset:%c2":"=&v"(hi[ks]):"v"(vb),"i"(d0*4096+ks*1024+512):"memory");}
    asm volatile("s_waitcnt lgkmcnt(0)":::"memory");SBAR();
    #define PK(k) (bf16x8){lo[k][0],lo[k][1],lo[k][2],lo[k][3],hi[k][0],hi[k][1],hi[k][2],hi[k][3]}
    o[d0]=__builtin_amdgcn_mfma_f32_32x32x16_bf16(pa0,PK(0),o[d0],0,0,0);
    o[d0]=__builtin_amdgcn_mfma_f32_32x32x16_bf16(pa1,PK(1),o[d0],0,0,0);
    o[d0]=__builtin_amdgcn_mfma_f32_32x32x16_bf16(pa2,PK(2),o[d0],0,0,0);
    o[d0]=__builtin_amdgcn_mfma_f32_32x32x16_bf16(pa3,PK(3),o[d0],0,0,0);
    #undef PK
  }
}

#ifndef ATTN_STORE16
#define ATTN_STORE16(p,v) (*(u32x4*)(p)=(v))
#endif
template<int THRL,int MODE> __device__ __forceinline__ void attn_unit(const bf16*Qu,const bf16*__restrict__ Kh,const bf16*__restrict__ Vh,bf16*Ou,const int DM,const int OP,const int NT,char*shm,
                                                                     const int q0,const int base,const int nrows,const float sinkl2,const __attribute__((address_space(3))) float*rpb){
  const int tid=threadIdx.x,lane=tid&63,r32=lane&31,hi=lane>>5; const int wid=__builtin_amdgcn_readfirstlane(tid>>6);
  const bf16*Qw=Qu+(long)(wid*QBLK)*DM;
  const unsigned lds0=(unsigned)(uintptr_t)shm;
  float*wsf=(float*)(shm+LDS_WS)+wid*64;
  const unsigned koff=(unsigned)(lane*DM+wid*8)*2u;
  const unsigned voff0=(unsigned)((16*(wid&3)+(lane>>2))*DM+(wid>>2)*32+(lane&3)*8)*2u;
  const unsigned kdst=lds0+LDS_K+wid*1024, vdst=lds0+LDS_V+wid*1024;
  #define ROWOFF(t) ((t)<4?8192+64*(t):(MODE==2&&(t)-4>=nrows?base:base+64*((t)-4)))
  #define DMA_K(t,slot) glds16s(Kh+(long)ROWOFF(t)*DM,koff,(unsigned)__builtin_amdgcn_readfirstlane(kdst+(slot)))
  #define DMA_V(t,slot) glds16s(Vh+(long)ROWOFF(t)*DM,voff0,(unsigned)__builtin_amdgcn_readfirstlane(vdst+(slot)))
  const char*Kbase=shm+LDS_K;
  #define KLD(ko,i) (*(const __attribute__((address_space(3))) bf16x8*)(kp0+(ko)+((i)>>1)*2048+((i)&1)*512))
  const lds_cptr shm3=(lds_cptr)shm; const lds_cptr kp0=shm3+LDS_K+hi*1024+r32*16; const lds_cptr vp0=shm3+LDS_V+((lane>>4)&1)*32+(lane&3)*8+(4*hi+((lane&15)>>2))*64;
  if(wid>=4)__builtin_amdgcn_s_setprio(1);
  DMA_K(0,0);DMA_V(0,0);DMA_K(1,SLOTB);
  bf16x8 qr[4];
  #pragma unroll
  for(int d0=0;d0<4;++d0)qr[d0]=*reinterpret_cast<const bf16x8*>(&Qw[(long)r32*DM+d0*16+hi*8]);
  const __attribute__((address_space(3))) bf16x8* qlp=(const __attribute__((address_space(3))) bf16x8*)(shm3+LDS_OST+wid*4096+lane*16);
  #pragma unroll
  for(int d0=0;d0<4;++d0)*(__attribute__((address_space(3))) bf16x8*)(shm3+LDS_OST+wid*4096+lane*16+d0*1024)=qr[d0];
  float mhat=0.f,l_reg=0.f;f32x16 o[2];o[0]=f32x16{};o[1]=f32x16{};f32x16 negm=f32x16{};asm volatile("":"+v"(negm));
  const int qpos=q0+wid*QBLK+r32;
  const int rq=(q0+wid*QBLK)>>6,cq=qpos&63;
  const int r0q=rq-4<0?0:(rq-4>120?120:rq-4), csq=cq-8<0?0:(cq-8>48?48:cq-8);
  #define CMASK(P0,P1,t) do{ if((t)>=4){ \
      if(MODE==1){ const int d_=qpos-(base+64*((t)-4)+4*hi); \
        _Pragma("unroll") for(int r=0;r<16;++r){ const int dd=d_-((r&3)+8*(r>>2)); if(dd>128||dd<-128)P0[r]=-INFINITY; if(dd-32>128||dd-32<-128)P1[r]=-INFINITY; } } \
      else { const int kr_=(base>>6)+(t)-4; const bool rok_=((t)-4<nrows)&&kr_>=r0q&&kr_<r0q+8; \
        const __attribute__((address_space(3))) float*bp_=rpb+((rok_?kr_-rq+7:7)*31+15-cq); \
        _Pragma("unroll") for(int r=0;r<16;++r){ const int k0_=(r&3)+8*(r>>2)+4*hi,k1_=k0_+32; \
          if(rok_&&k0_>=csq&&k0_<csq+16)P0[r]+=bp_[k0_]; else P0[r]=-INFINITY; \
          if(rok_&&k1_>=csq&&k1_<csq+16)P1[r]+=bp_[k1_]; else P1[r]=-INFINITY; } } } }while(0)
  bool resc=false;
  #define START(P0,P1) do{ const float rm=rowmax(P0,P1); resc=false; \
    { const float dl=rm; mhat=fadd_s(mhat,dl); \
      _Pragma("unroll") for(int r=0;r<16;++r){P0[r]=fsub_s(P0[r],dl);P1[r]=fsub_s(P1[r],dl);} \
      _Pragma("unroll") for(int r=0;r<16;++r)negm[r]=-mhat; asm volatile("":"+v"(negm)); } \
    _Pragma("unroll") for(int r=0;r<16;++r)P0[r]=__builtin_amdgcn_exp2f(P0[r]); }while(0)
  #define RESC() do{ if(resc){ asm volatile("s_waitcnt lgkmcnt(0)":::"memory"); \
      _Pragma("unroll") for(int d_=0;d_<2;++d_) _Pragma("unroll") for(int r=0;r<16;++r)o[d_][r]*=wsf[crow(r,hi)]; } }while(0)
  f32x16 c0,c1;
  u32x4 pwA0,pwA1,pwA2,pwA3,pwB0,pwB1,pwB2,pwB3;
  int sl_prev=0,sl_cur=0,sl_next=SLOTB;
  int kc=0;
  #define KNEXT(n) ((kc+(n)*SLOTB)&(KSLOTS*SLOTB-1))
  #define ROT() do{sl_prev=sl_cur;sl_cur=sl_next;sl_next=(sl_next==(NSLOT-1)*SLOTB)?0:sl_next+SLOTB;kc=KNEXT(1);}while(0)
  #define PKW(P,B) cvtpk_s(P[B],P[B+1])
  DMA_K(2,2*SLOTB);
  WAIT_BAR(3);
  qkt(c0,c1,Kbase,qr,negm,r32,hi);asm volatile("s_nop 15\n\ts_nop 7":"+v"(c0),"+v"(c1));CMASK(c0,c1,0);
  START(c0,c1);
  _Pragma("unroll") for(int r=0;r<16;++r)c1[r]=__builtin_amdgcn_exp2f(c1[r]);
  { float sacc=c0[0]+c0[1]; _Pragma("unroll") for(int r=2;r<16;++r)sacc+=c0[r]; _Pragma("unroll") for(int r=0;r<16;++r)sacc+=c1[r]; l_reg+=sacc;
    pwA0=(u32x4){PKW(c0,0),PKW(c0,2),PKW(c0,4),PKW(c0,6)};pwA1=(u32x4){PKW(c0,8),PKW(c0,10),PKW(c0,12),PKW(c0,14)};pwA2=(u32x4){PKW(c1,0),PKW(c1,2),PKW(c1,4),PKW(c1,6)};pwA3=(u32x4){PKW(c1,8),PKW(c1,10),PKW(c1,12),PKW(c1,14)}; }
  WAIT_BAR(0);
  DMA_K(3,3*SLOTB);DMA_V(1,SLOTB);
  ROT();
  bf16x8 ka0=KLD(kc,0),ka1=KLD(kc,1);
  WAIT_BAR(2);
  s16x4 vlo[4],vhi[4]; bf16x8 q0_=qr[0],q1_=qr[1];
  #define PAF(S,k) __builtin_bit_cast(bf16x8,pw##S##k)
  #define VFR(i) (bf16x8){vlo[i][0],vlo[i][1],vlo[i][2],vlo[i][3],vhi[i][0],vhi[i][1],vhi[i][2],vhi[i][3]}
  #define PIN(x) asm volatile("":"+v"(x))
  #define MX3(a,b,c) __builtin_fmaxf(__builtin_fmaxf((a),(b)),(c))
  #define EX(v) __builtin_amdgcn_exp2f(v)
  #define GAPA(MF) do{ MF; SBAR(); }while(0)
  #define GAPB(MF,X,B,PWV,WI,RL) do{ MF; X[B]=EX(X[B]); X[B+1]=EX(X[B+1]); X[B+2]=EX(X[B+2]); X[B+3]=EX(X[B+3]); sacc+=X[B]; sacc+=X[B+1]; sacc+=X[B+2]; sacc+=X[B+3]; PWV[WI]=PKW(X,B); PWV[WI+1]=PKW(X,B+2); PIN(PWV); PIN(sacc); RL; SBAR(); }while(0)
  #define VRD(s,d,ks) do{ vlo[s]=vtr(vp_+((d)*4096+(ks)*1024)); vhi[s]=vtr(vp_+((d)*4096+(ks)*1024+512)); }while(0)
  #define KRD(G,j) do{ if(G){ kload2(kf,kp0+sl_next,j); SBAR(); } }while(0)
  #define NOP_() do{}while(0)
  #define MF32(a,b,c) __builtin_amdgcn_mfma_f32_32x32x16_bf16(a,b,c,0,0,0)
  #define STEP(N,O,t,GK,GV,GL) do{ SBAR(); \
    const lds_cptr vp_=vp0+sl_prev; \
    const bf16x8 kb2=KLD(kc,2),kb3=KLD(kc,3); const bf16x8 q2_=qlp[128]; SBAR(); GAPA(c0=MF32(ka0,q0_,negm)); \
    const bf16x8 q3_=qlp[192]; SBAR(); GAPA(c1=MF32(ka1,q0_,negm)); \
    const bf16x8 kb4=KLD(kc,4),kb5=KLD(kc,5); SBAR(); GAPA(c0=MF32(kb2,q1_,c0)); \
    GAPA(c1=MF32(kb3,q1_,c1)); \
    const bf16x8 kb6=KLD(kc,6),kb7=KLD(kc,7); VRD(0,0,0); SBAR(); GAPA(c0=MF32(kb4,q2_,c0)); \
    VRD(1,1,0); SBAR(); GAPA(c1=MF32(kb5,q2_,c1)); \
    VRD(2,0,1); SBAR(); GAPA(c0=MF32(kb6,q3_,c0)); \
    VRD(3,1,1); SBAR(); GAPA(c1=MF32(kb7,q3_,c1)); \
    if(GK){DMA_K((t)+3,KNEXT(3));} if(GV){DMA_V((t)+1,sl_next);} \
    CMASK(c0,c1,t); \
    { float a=MX3(c0[0],c0[1],c1[0]),b=MX3(c0[2],c0[3],c1[1]); a=MX3(a,c1[2],c1[3]); \
      _Pragma("unroll") for(int r=4;r<16;r+=4){a=MX3(a,c0[r],c0[r+1]);b=MX3(b,c0[r+2],c0[r+3]);a=MX3(a,c1[r],c1[r+1]);b=MX3(b,c1[r+2],c1[r+3]);} \
      float rm=__builtin_fmaxf(a,b); { auto rr=__builtin_amdgcn_permlane32_swap(__float_as_uint(rm),__float_as_uint(rm),false,false); rm=__builtin_fmaxf(__uint_as_float(rr[0]),__uint_as_float(rr[1])); } \
      resc=false; \
      if(__builtin_expect(__any(rm>(float)THRL),0)){ const float dl=__builtin_fmaxf(rm,0.f); mhat+=dl; \
        _Pragma("unroll") for(int r=0;r<16;++r){c0[r]-=dl;c1[r]-=dl;} \
        _Pragma("unroll") for(int r=0;r<16;++r)negm[r]=-mhat; asm volatile("":"+v"(negm)); \
        const float f=__builtin_amdgcn_exp2f(-dl); l_reg*=f; if(hi==0)wsf[r32]=f; resc=true; } } \
    SBAR(); float sacc=0.f; \
    GAPB(o[0]=MF32(PAF(O,0),VFR(0),o[0]), c0,0,  pw##N##0,0, VRD(0,0,2)); \
    GAPB(o[1]=MF32(PAF(O,0),VFR(1),o[1]), c0,4,  pw##N##0,2, VRD(1,1,2)); \
    GAPB(o[0]=MF32(PAF(O,1),VFR(2),o[0]), c0,8,  pw##N##1,0, VRD(2,0,3)); \
    GAPB(o[1]=MF32(PAF(O,1),VFR(3),o[1]), c0,12, pw##N##1,2, VRD(3,1,3)); \
    GAPB(o[0]=MF32(PAF(O,2),VFR(0),o[0]), c1,0,  pw##N##2,0, ka0=KLD(KNEXT(1),0)); \
    GAPB(o[1]=MF32(PAF(O,2),VFR(1),o[1]), c1,4,  pw##N##2,2, ka1=KLD(KNEXT(1),1)); \
    GAPB(o[0]=MF32(PAF(O,3),VFR(2),o[0]), c1,8,  pw##N##3,0, q0_=qlp[0]); \
    GAPB(o[1]=MF32(PAF(O,3),VFR(3),o[1]), c1,12, pw##N##3,2, q1_=qlp[64]); \
    l_reg+=sacc; \
    }while(0)
  int t=1;
  for(;t+5<NT;t+=2){
    STEP(B,A,t,true,true,true);     WAIT_BAR(2); RESC(); ROT();
    STEP(A,B,t+1,true,true,true);   WAIT_BAR(2); RESC(); ROT();
  }
  #define ENDW(tt) do{ if((tt)+3<NT){WAIT_BAR(2);} else if((tt)+2<NT){WAIT_BAR(1);} else {WAIT_BAR(0);} }while(0)
  for(;t+1<NT;t+=2){
    STEP(B,A,t,(t+3<NT),(t+1<NT),(t+1<NT));       ENDW(t);   RESC(); ROT();
    STEP(A,B,t+1,(t+4<NT),(t+2<NT),(t+2<NT));     ENDW(t+1); RESC(); ROT();
  }
  STEP(B,A,NT-1,false,false,false); RESC();
  { SBAR(); const int vb0=(int)(lds0+LDS_V)+((lane>>4)&1)*32+(lane&3)*8+(4*hi+((lane&15)>>2))*64; pv(o,vb0+sl_cur,PAF(B,0),PAF(B,1),PAF(B,2),PAF(B,3)); }
  #undef PKW
  #undef PAF
  #undef VFR
  #undef PIN
  #undef MX3
  #undef GAPA
  #undef GAPB
  #undef EX
  #undef VRD
  #undef KRD
  #undef STEP
  #undef KLD
  #undef KNEXT
  #undef NOP_
  #undef MF32
  #undef ENDW
  {auto rr=__builtin_amdgcn_permlane32_swap(__float_as_uint(l_reg),__float_as_uint(l_reg),false,false);l_reg=__uint_as_float(rr[0])+__uint_as_float(rr[1]);}
  if(MODE==1)l_reg+=__builtin_amdgcn_exp2f(sinkl2-mhat);
  if(hi==0)wsf[32+r32]=l_reg;asm volatile("s_waitcnt lgkmcnt(0)":::"memory");
  float rli[16];
  #pragma unroll
  for(int r=0;r<16;++r)rli[r]=__builtin_amdgcn_rcpf(wsf[32+crow(r,hi)]);
  bf16*Ow=Ou+(long)(wid*QBLK)*OP;
  { bf16*stg=(bf16*)(shm+LDS_OST)+wid*2048;
    #pragma unroll
    for(int r=0;r<16;++r){const int orow=crow(r,hi);
      #pragma unroll
      for(int d0=0;d0<2;++d0)stg[orow*64+d0*32+r32]=__float2bfloat16(o[d0][r]*rli[r]);}
    asm volatile("s_waitcnt lgkmcnt(0)":::"memory");
    #pragma unroll
    for(int i=0;i<4;++i){const int row=i*8+(lane>>3),ch=lane&7; const u32x4 v=*(const u32x4*)(stg+row*64+ch*8); ATTN_STORE16(Ow+(long)row*OP+ch*8,v);} }
  asm volatile("s_waitcnt lgkmcnt(0)\n\ts_barrier":::"memory");
  if(wid>=4)__builtin_amdgcn_s_setprio(0);
  #undef DMA_K
  #undef ROWOFF
  #undef DMA_V
  #undef CMASK
  #undef START
  #undef RESC
  #undef ROT
}
constexpr int ATTN_LDS_BYTES=LDS_BYTES;
}

struct Args { const float* in[24]; float* out; unsigned char* ws; int ph_lo, ph_hi; };
struct Ctx {
    char* lds; int tid, lane, wid, bid, nblk, vcu;
    const float* const* in; float* out; unsigned char* ws;
};
#define WSP(T, off) ((T*)(C.ws + (off)))

__device__ __forceinline__ const float* hin_row(const Ctx& C, int row) {
    const int b = row / SP, t = row - b * SP;
    return t < SEQ ? C.in[0] + ((size_t)b * SEQ + t) * D : C.in[2] + ((size_t)b * NCTX + (t - SEQ)) * D;
}
__device__ __forceinline__ int row_set(int row) { const int b = row / SP, t = row - b * SP; return t < SEQ ? b : 2; }

struct ConvTile { const float* src; bf16_t* dst; int K, N; };
__device__ __forceinline__ ConvTile conv_decode(const Ctx& C, int tile) {
    constexpr int T_WIN = 144, T_WOUT = 64, T_EXP = 2048;
    ConvTile t; int m, ti;
    if (tile < 2 * T_WIN) { m = tile / T_WIN; ti = tile % T_WIN; t.src = C.in[m ? 13 : 8]; t.dst = WSP(bf16_t, WS_WIN) + (size_t)m * NQKV * D; t.K = D; t.N = NQKV; }
    else if ((tile -= 2 * T_WIN) < 2 * T_WOUT) { m = tile / T_WOUT; ti = tile % T_WOUT; t.src = C.in[m ? 14 : 9]; t.dst = WSP(bf16_t, WS_WOUT) + (size_t)m * D * D; t.K = D; t.N = D; }
    else if ((tile -= 2 * T_WOUT) < T_EXP) { m = tile >> 5; ti = tile & 31; t.src = C.in[21] + (size_t)m * 524288; t.dst = WSP(bf16_t, WS_W1) + (size_t)m * 524288; t.K = 1024; t.N = 512; }
    else if ((tile -= T_EXP) < T_EXP) { m = tile >> 5; ti = tile & 31; t.src = C.in[22] + (size_t)m * 524288; t.dst = WSP(bf16_t, WS_W3) + (size_t)m * 524288; t.K = 1024; t.N = 512; }
    else { tile -= T_EXP; m = tile >> 5; ti = tile & 31; t.src = C.in[23] + (size_t)m * 524288; t.dst = WSP(bf16_t, WS_W2) + (size_t)m * 524288; t.K = 512; t.N = 1024; }
    const int nn = t.N >> 8; const int kt = ti / nn, nt = ti % nn;
    t.src += (size_t)(kt * 64) * t.N + nt * 256; t.dst += (size_t)(nt * 256) * t.K + kt * 64;
    return t;
}
constexpr int CONV_EARLY = 2 * 144 + 2 * 64, CONV_TILES = CONV_EARLY + 3 * 2048;
constexpr int CW_NORM = 20480;
__device__ __forceinline__ ConvTile conv_decode_exp(const Ctx& C, int tile) {
    tile -= CONV_EARLY;
    const int cls = tile >> 11, m = (tile >> 5) & 63, ti = tile & 31;
    const int lg = cls < 2 ? 1 : 2;
    const int kt = ti >> lg, nt = ti & ((1 << lg) - 1);
    ConvTile t; t.N = 256 << lg; t.K = 2048 >> lg;
    const size_t wsoff = cls == 0 ? WS_W1 : (cls == 1 ? WS_W3 : WS_W2);
    t.src = C.in[21 + cls] + (size_t)m * 524288 + (size_t)(kt * 64) * t.N + nt * 256;
    t.dst = (bf16_t*)(C.ws + wsoff) + (size_t)m * 524288 + (size_t)(nt * 256) * t.K + kt * 64;
    return t;
}
template <bool EXP, int NT>
__device__ __forceinline__ void conv_tiles(const Ctx& C, int first, int step, int end) {
    int tid = C.tid; asm volatile("" : "+v"(tid));
    const int lane = tid & 63, wid = __builtin_amdgcn_readfirstlane(tid >> 6), kg = lane & 7, nq = lane >> 3;
    const int ncol = wid * 32 + nq * 4;
    f32x4 v[4][8];
#define CONV_LD(i_, tile_) do { const ConvTile t_ = EXP ? conv_decode_exp(C, (tile_)) : conv_decode(C, (tile_)); _Pragma("unroll") for (int r_ = 0; r_ < 8; ++r_) \
        v[i_][r_] = __builtin_nontemporal_load((const f32x4*)(t_.src + (size_t)(kg * 8 + r_) * t_.N + ncol)); __builtin_amdgcn_sched_barrier(0); } while (0)
#define CONV_ST(i_, tile_) do { const ConvTile t_ = EXP ? conv_decode_exp(C, (tile_)) : conv_decode(C, (tile_)); _Pragma("unroll") for (int j_ = 0; j_ < 4; ++j_) { u32x4 o_; \
        o_.x = cvtpk(v[i_][0][j_], v[i_][1][j_]); o_.y = cvtpk(v[i_][2][j_], v[i_][3][j_]); o_.z = cvtpk(v[i_][4][j_], v[i_][5][j_]); o_.w = cvtpk(v[i_][6][j_], v[i_][7][j_]); \
        __builtin_nontemporal_store(o_, (u32x4*)(t_.dst + (size_t)(ncol + j_) * t_.K + kg * 8)); } __builtin_amdgcn_sched_barrier(0); } while (0)
    if constexpr (NT > 0) {
#pragma unroll
        for (int j = 0; j < 4 && j < NT; ++j) CONV_LD(j, first + j * step);
#pragma unroll
        for (int j = 0; j < NT; ++j) { CONV_ST(j % 4, first + j * step); if (j + 4 < NT) CONV_LD(j % 4, first + (j + 4) * step); }
    } else {
        int tile = first;
#pragma unroll
        for (int i = 0; i < 4; ++i) if (tile + i * step < end) CONV_LD(i, tile + i * step);
        while (tile < end) {
#pragma unroll
            for (int i = 0; i < 4; ++i) {
                const int cur = tile + i * step, nxt = cur + 4 * step;
                if (cur < end) { CONV_ST(i, cur); if (nxt < end) CONV_LD(i, nxt); }
            }
            tile += 4 * step;
        }
    }
#undef CONV_LD
#undef CONV_ST
}
__device__ __forceinline__ void phase_prologue(const Ctx& C) {
    const int tid = C.tid;
    {
        float* sv = (float*)C.lds;
        float* red = (float*)(C.lds + 12288);
        for (int i = tid; i < 3072; i += NTHR) { const int set = i >> 10, k = i & 1023; const float v = set < 2 ? C.in[1][set * D + k] : C.in[3][k]; sv[i] = silu_f(v); }
        __syncthreads();
        float* mods = WSP(float, WS_MODS);
        for (int item = C.bid; item < 256; item += C.nblk) {
            const int layer = item >> 7, col0 = (item & 127) * 48;
            if (tid < 384) {
                const int cg = tid % 12, ks = tid / 12;
                f32x4 a0 = {0, 0, 0, 0}, a1 = a0, a2 = a0;
                const float* W = C.in[4] + (size_t)layer * D * 6144 + col0 + cg * 4;
                for (int kk = 0; kk < 32; ++kk) {
                    const int k = ks * 32 + kk;
                    const f32x4 w = *(const f32x4*)(W + (size_t)k * 6144);
                    a0 += sv[k] * w; a1 += sv[1024 + k] * w; a2 += sv[2048 + k] * w;
                }
                float* rp = red + (ks * 12 + cg) * 12;
                *(f32x4*)(rp) = a0; *(f32x4*)(rp + 4) = a1; *(f32x4*)(rp + 8) = a2;
            }
            __syncthreads();
            if (tid < 144) {
                const int cg = tid / 12, v = tid % 12;
                float s = 0.f;
                for (int ks = 0; ks < 32; ++ks) s += red[(ks * 12 + cg) * 12 + v];
                const int set = v >> 2, col = col0 + cg * 4 + (v & 3);
                mods[(layer * 3 + set) * 6144 + col] = s + C.in[5][layer * 6144 + col];
            }
            __syncthreads();
        }
    }
    {
        float* cs = WSP(float, WS_ROPE); float* sn = cs + SEQ * 32;
        for (int idx = C.bid * NTHR + tid; idx < SEQ * 32; idx += C.nblk * NTHR) {
            const int t = idx >> 5, j = idx & 31;
            const float pos = (float)(j < 16 ? (t >> 6) : (t & 63));
            const float inv = powf(10000.f, -(float)(j & 15) / 16.f);
            const float ang = pos * inv;
            float s, c; sincosf(ang, &s, &c);
            cs[idx] = c; sn[idx] = s;
        }
    }
    __syncthreads();
    conv_tiles<false, 0>(C, C.bid, C.nblk, CONV_EARLY);
}

__device__ __forceinline__ void store_row_bf16(bf16_t* rowp, int lane, const u32x2 (&o)[4]) {
    const bool odd = (lane & 1) != 0;
#pragma unroll
    for (int gp = 0; gp < 2; ++gp) {
        const u32x2 send = odd ? o[2 * gp] : o[2 * gp + 1];
        u32x2 recv; recv.x = (unsigned)__shfl_xor((int)send.x, 1); recv.y = (unsigned)__shfl_xor((int)send.y, 1);
        u32x4 v;
        if (!odd) { v.x = o[2 * gp].x; v.y = o[2 * gp].y; v.z = recv.x; v.w = recv.y; }
        else { v.x = recv.x; v.y = recv.y; v.z = o[2 * gp + 1].x; v.w = o[2 * gp + 1].y; }
        st16_wt(rowp + 256 * (2 * gp + (odd ? 1 : 0)) + 8 * (lane >> 1), v);
    }
}
__device__ __forceinline__ void phase_mod0(const Ctx& C) {
    const float* mods = WSP(float, WS_MODS);
    bf16_t* act = WSP(bf16_t, WS_ACT);
    for (int row = C.bid * 8 + C.wid; row < R; row += C.nblk * 8) {
        const float* src = hin_row(C, row); const float* m = mods + row_set(row) * 6144;
        u32x2 ob[4];
#pragma unroll
        for (int i = 0; i < 4; ++i) {
            const int col = C.lane * 4 + 256 * i;
            const f32x4 v = *(const f32x4*)(src + col), sh = *(const f32x4*)(m + col), sc = *(const f32x4*)(m + 1024 + col);
            const f32x4 a = v * (1.f + sc) + sh;
            ob[i].x = cvtpk(a[0], a[1]); ob[i].y = cvtpk(a[2], a[3]);
        }
        store_row_bf16(act + (size_t)row * D, C.lane, ob);
    }
    {
        const bf16_t* wo = WSP(bf16_t, WS_WOUT); bf16_t* wg = WSP(bf16_t, WS_WG);
        for (int row = C.bid * 8 + C.wid; row < 6 * D; row += C.nblk * 8) {
            const int ls = row >> 10, n = row & 1023, l = ls / 3;
            const float g = mods[(size_t)ls * 6144 + 2 * 1024 + n] * (1.f / ALPHA);
#pragma unroll
            for (int hf = 0; hf < 2; ++hf) {
                const u32x4 w = *(const u32x4*)(wo + ((size_t)l * D + n) * D + hf * 512 + C.lane * 8);
                u32x4 o;
                o.x = cvtpk(bf2f((unsigned short)(w.x & 0xffff)) * g, bf2f((unsigned short)(w.x >> 16)) * g); o.y = cvtpk(bf2f((unsigned short)(w.y & 0xffff)) * g, bf2f((unsigned short)(w.y >> 16)) * g);
                o.z = cvtpk(bf2f((unsigned short)(w.z & 0xffff)) * g, bf2f((unsigned short)(w.z >> 16)) * g); o.w = cvtpk(bf2f((unsigned short)(w.w & 0xffff)) * g, bf2f((unsigned short)(w.w >> 16)) * g);
                *(u32x4*)(wg + (size_t)row * D + hf * 512 + C.lane * 8) = o;
            }
        }
    }
}

__device__ __forceinline__ int xcd_item(const Ctx& C, int it) { return it * C.nblk + C.vcu; }
#define GEMM_SRC_CHUNK(tid) ((((tid) & 7) ^ ((((tid) >> 3) >> 1) & 7)))
constexpr int GEMM_LDS = 147456;
template <int KT, int NMI, bool PART = false, bool INIT = false>
__device__ __forceinline__ void gemm_core(char* lds, const bf16_t* const (&rp)[NMI + 4], f32x16 (&acc)[NMI][2], int tid, int nvalid = 256) {
    constexpr int AR = NMI * 64, NP = NMI + 4, STAGE = (AR + 256) * 128, SLOTS = NMI == 2 ? 3 : 2, PF = SLOTS - 1;
    static_assert(SLOTS * STAGE <= GEMM_LDS, "gemm ring");
    const int lane = tid & 63, wid = __builtin_amdgcn_readfirstlane(tid >> 6), r32 = lane & 31, hi = lane >> 5;
    const int wn = wid >> 2, wt = wid & 3;
    const int sw = (r32 >> 1) & 7;
    const int arow = (wn * (NMI * 32) + r32) * 128, brow = (AR + wt * 64 + r32) * 128;
    if constexpr (!INIT) {
#pragma unroll
        for (int mi = 0; mi < NMI; ++mi)
#pragma unroll
            for (int ti = 0; ti < 2; ++ti)
#pragma unroll
                for (int r = 0; r < 16; ++r) acc[mi][ti][r] = 0.f;
    }
    LAS char* l3 = (LAS char*)lds;
    const bool act0 = !PART || nvalid > wt * 64, act1 = !PART || nvalid > wt * 64 + 32;
#define GEMM_PIECE_ON(i_) (!PART || (i_) < NMI || 8 * (wid + 8 * (i_)) - AR < nvalid)
#define GEMM_DMA(kt_, slot_) do { _Pragma("unroll") for (int i_ = 0; i_ < NP; ++i_) if (GEMM_PIECE_ON(i_)) \
        __builtin_amdgcn_global_load_lds((const unsigned*)(rp[i_] + (kt_) * 64), (LAS unsigned*)(l3 + (slot_) * STAGE + (wid + 8 * i_) * 1024), 16, 0, 0); } while (0)
#define GEMM_WAIT(ntiles_) do { if (PART || (ntiles_) <= 0) asm volatile("s_waitcnt vmcnt(0)" ::: "memory"); else if (NP == 6) asm volatile("s_waitcnt vmcnt(6)" ::: "memory"); else asm volatile("s_waitcnt vmcnt(8)" ::: "memory"); } while (0)
    GEMM_DMA(0, 0);
    if (PF > 1 && KT > 1) { GEMM_DMA(1, 1); GEMM_WAIT(1); } else { GEMM_WAIT(0); }
    __builtin_amdgcn_s_barrier();
#pragma unroll
    for (int kt = 0; kt < KT; ++kt) {
        const char* cur = lds + (kt % SLOTS) * STAGE;
        __builtin_amdgcn_sched_barrier(0);
#pragma unroll
        for (int ks = 0; ks < 4; ++ks) {
            const int co = ((2 * ks + hi) ^ sw) << 4;
            bf16x8 a[NMI];
#pragma unroll
            for (int mi = 0; mi < NMI; ++mi) a[mi] = *(const bf16x8*)(cur + arow + mi * 32 * 128 + co);
            bf16x8 b0 = {}, b1 = {};
            if (act0) b0 = *(const bf16x8*)(cur + brow + co);
            if (act1) b1 = *(const bf16x8*)(cur + brow + 32 * 128 + co);
            if (kt + PF < KT) {
#pragma unroll
                for (int i_ = ks * NP / 4; i_ < (ks + 1) * NP / 4; ++i_) if (GEMM_PIECE_ON(i_))
                    __builtin_amdgcn_global_load_lds((const unsigned*)(rp[i_] + (kt + PF) * 64), (LAS unsigned*)(l3 + ((kt + PF) % SLOTS) * STAGE + (wid + 8 * i_) * 1024), 16, 0, 0);
            }
            __builtin_amdgcn_s_setprio(1);
            if (act0) {
#pragma unroll
                for (int mi = 0; mi < NMI; ++mi) acc[mi][0] = mfma32(a[mi], b0, acc[mi][0]);
            }
            if (act1) {
#pragma unroll
                for (int mi = 0; mi < NMI; ++mi) acc[mi][1] = mfma32(a[mi], b1, acc[mi][1]);
            }
            __builtin_amdgcn_s_setprio(0);
            __builtin_amdgcn_sched_barrier(0);
        }
        if (kt + 1 < KT) { GEMM_WAIT((kt + PF < KT ? kt + PF : KT - 1) - (kt + 1)); }
        __builtin_amdgcn_s_barrier();
    }
#undef GEMM_DMA
#undef GEMM_WAIT
#undef GEMM_PIECE_ON
}

template <int NCOL> struct WStage { static constexpr int P = NCOL * 2 + 16, BYTES = 64 * P, CH = NCOL / 8; };
template <int NCOL>
__device__ __forceinline__ void stage_put(char* wbuf, int row, int col, u32x2 v) { *(u32x2*)(wbuf + row * WStage<NCOL>::P + col * 2) = v; }
template <int NCOL>
__device__ __forceinline__ void stage_flush(const char* wbuf, int lane, bf16_t* base, size_t pitch, int nvalid) {
    constexpr int CH = WStage<NCOL>::CH;
    __builtin_amdgcn_sched_barrier(0);
#pragma unroll 4
    for (int i = 0; i < CH; ++i) {
        const int idx = i * 64 + lane, row = idx / CH, ch = idx % CH;
        const u32x4 v = *(const u32x4*)(wbuf + row * WStage<NCOL>::P + ch * 16);
        if (row < nvalid) st16_wt(base + (size_t)row * pitch + ch * 8, v);
    }
}


__device__ __forceinline__ void st16_sel(void* p, u32x4 v, bool wt) { if (wt) st16_wt(p, v); else *(u32x4*)p = v; }
namespace pg8 {
constexpr int BM = 256, BK = 64, HALF = 128, HTB = HALF * BK * 2  , STAGE_BYTES = 8 * HTB;
__device__ __forceinline__ int lds_byte(int r, int c) { const int st = (r >> 4) * 2 + (c >> 5), rr = r & 15, cc = c & 31, ob = rr * 64 + cc * 2; return st * 1024 + (ob ^ (((ob >> 9) & 1) << 5)); }
__device__ __forceinline__ void stage_rc(int b, int& R, int& Cc) { const int st = b / 1024, sb = b % 1024, swz = sb ^ (((sb >> 9) & 1) << 5); R = (st >> 1) * 16 + swz / 64; Cc = (st & 1) * 32 + (swz % 64) / 2; }
__device__ __forceinline__ int perm32(int rho) { const int n = rho >> 4, i = rho & 15; return 8 * (i >> 2) + 4 * n + (i & 3); }
struct Unit { int pm, pn, e, lt, cnt, row0; };
template <class Epi, class Sched>
__device__ __forceinline__ void gemm_phase(LAS unsigned char* lds, const int K, const Sched& S, const Epi& E, int tid) {
    const int wid = __builtin_amdgcn_readfirstlane(tid >> 6), lane = tid & 63, wr = wid >> 2, wc = wid & 3, fr = lane & 15, fq = lane >> 4;
    const int nt = K / BK;
    unsigned voffB[2], cva[2][2], nva[2][2]; int sR[2], sC[2];
#pragma unroll
    for (int i = 0; i < 2; ++i) { stage_rc(tid * 16 + i * 8192, sR[i], sC[i]); voffB[i] = (unsigned)(Epi::brow(sR[i]) * K + sC[i]) * 2u;
        cva[0][i] = cva[1][i] = nva[0][i] = nva[1][i] = (unsigned)(sR[i] * K + sC[i]) * 2u; }
    const size_t kstep = (size_t)(BK * 2);
    const size_t hstepA = Epi::GATHER ? (size_t)0 : (size_t)HALF * K * 2, hstepB = Epi::bstep(K);
#define PG8_GATHER(va, u) do { if constexpr (Epi::GATHER) { _Pragma("unroll") for (int h_ = 0; h_ < 2; ++h_) _Pragma("unroll") for (int i_ = 0; i_ < 2; ++i_) \
        va[h_][i_] = (unsigned)(E.arow(u, h_ * HALF + sR[i_]) * K + sC[i_]) * 2u; } } while (0)
    const unsigned ldsw = (unsigned)wid * 1024u;
    const int aoff = lds_byte(wr * 64 + fr, fq * 8), boff = lds_byte(wc * 32 + fr, fq * 8);
#define PG8_SA(b, h) (((b) * 2 + (h)) * HTB)
#define PG8_SB(b, h) ((4 + (b) * 2 + (h)) * HTB)
#define PG8_STAGE(bufoff, gbase, voff) do { _Pragma("unroll") for (int _i = 0; _i < 2; ++_i) \
        __builtin_amdgcn_global_load_lds((const unsigned*)((const char*)(gbase) + (voff)[_i]), (LAS unsigned*)(lds + (bufoff) + ldsw + _i * 8192), 16, 0, 0); } while (0)
#define PG8_LDA(dst, b, h) do { _Pragma("unroll") for (int m = 0; m < 4; ++m) _Pragma("unroll") for (int k = 0; k < 2; ++k) dst[m][k] = *(const LAS bf16x8*)(lds + PG8_SA(b, h) + aoff + m * 2048 + k * 1024); } while (0)
#define PG8_LDB(dst, b, h) do { _Pragma("unroll") for (int n = 0; n < 2; ++n) _Pragma("unroll") for (int k = 0; k < 2; ++k) dst[n][k] = *(const LAS bf16x8*)(lds + PG8_SB(b, h) + boff + n * 2048 + k * 1024); } while (0)
#define PG8_MMA(ai, bj, At, Bt) do { __builtin_amdgcn_s_setprio(1); _Pragma("unroll") for (int m = 0; m < 4; ++m) _Pragma("unroll") for (int n = 0; n < 2; ++n) _Pragma("unroll") for (int k = 0; k < 2; ++k) \
        acc[ai][bj][m][n] = __builtin_amdgcn_mfma_f32_16x16x32_bf16(Bt[n][k], At[m][k], acc[ai][bj][m][n], 0, 0, 0); __builtin_amdgcn_s_setprio(0); } while (0)
#define PG8_WAIT_V(n) asm volatile("s_waitcnt vmcnt(" #n ")" ::: "memory")
#define PG8_WAIT_L(n) asm volatile("s_waitcnt lgkmcnt(" #n ")" ::: "memory")
#define PG8_BAR __builtin_amdgcn_s_barrier()
#define PG8_SCHED __builtin_amdgcn_sched_barrier(0)
    Unit cur, nxt, nn; int ui = 0;
    if (!S.next(0, cur)) return;
    bool has_next = S.next(1, nxt);
    int prow[2][2] = {{0, 0}, {0, 0}};
#define PG8_ROWS(u) do { if constexpr (Epi::GATHER) { _Pragma("unroll") for (int h_ = 0; h_ < 2; ++h_) _Pragma("unroll") for (int i_ = 0; i_ < 2; ++i_) prow[h_][i_] = E.arow(u, h_ * HALF + sR[i_]); } } while (0)
    f32x4 acc[2][2][4][2];
    E.init(acc, cur, wr, wc, fr, fq);
    bf16x8 At[4][2], B0[2][2], B1[2][2];
    const char* cA = E.A(cur); const char* cB = E.B(cur);
    PG8_GATHER(cva, cur);
    if (has_next) PG8_ROWS(nxt);
    PG8_STAGE(PG8_SB(0, 0), cB, voffB); PG8_STAGE(PG8_SA(0, 0), cA, cva[0]); PG8_STAGE(PG8_SB(0, 1), cB + hstepB, voffB); PG8_STAGE(PG8_SA(0, 1), cA + hstepA, cva[1]);
    if (wr == 1) PG8_BAR;
    PG8_WAIT_V(4); PG8_BAR;
    PG8_STAGE(PG8_SB(1, 0), cB + kstep, voffB); PG8_STAGE(PG8_SA(1, 0), cA + kstep, cva[0]); PG8_STAGE(PG8_SB(1, 1), cB + hstepB + kstep, voffB);
    PG8_WAIT_V(6); PG8_BAR;
    for (;;) {
        const char* nA = has_next ? E.A(nxt) : cA; const char* nB = has_next ? E.B(nxt) : cB;
        if constexpr (Epi::GATHER) { if (has_next) { _Pragma("unroll") for (int h_ = 0; h_ < 2; ++h_) _Pragma("unroll") for (int i_ = 0; i_ < 2; ++i_) nva[h_][i_] = (unsigned)(prow[h_][i_] * K + sC[i_]) * 2u; } }
        const bool has_nn = has_next && S.next(ui + 2, nn);
        if (has_nn) PG8_ROWS(nn);
        for (int t = 0; t < nt; t += 2) {
            const bool last = (t == nt - 2);
            const char* a1 = cA + (size_t)(t + 1) * kstep;
            const char* a2 = last ? nA : cA + (size_t)(t + 2) * kstep; const char* b2 = last ? nB : cB + (size_t)(t + 2) * kstep;
            const char* a3 = a2 + kstep; const char* b3 = b2 + kstep;
            unsigned va0[2], va1[2];
#pragma unroll
            for (int i_ = 0; i_ < 2; ++i_) { va0[i_] = last ? nva[0][i_] : cva[0][i_]; va1[i_] = last ? nva[1][i_] : cva[1][i_]; }
            PG8_LDB(B0, 0, 0); PG8_SCHED; PG8_LDA(At, 0, 0); PG8_STAGE(PG8_SA(1, 1), a1 + hstepA, cva[1]);
            PG8_WAIT_L(8); PG8_BAR; PG8_WAIT_L(0); PG8_MMA(0, 0, At, B0); PG8_BAR; PG8_SCHED;
            PG8_LDB(B1, 0, 1); PG8_STAGE(PG8_SB(0, 0), b2, voffB);
            PG8_BAR; PG8_WAIT_L(0); PG8_MMA(0, 1, At, B1); PG8_BAR;
            PG8_LDA(At, 0, 1); PG8_STAGE(PG8_SA(0, 0), a2, va0);
            PG8_BAR; PG8_WAIT_L(0); PG8_MMA(1, 0, At, B0); PG8_BAR; PG8_SCHED;
            PG8_STAGE(PG8_SB(0, 1), b2 + hstepB, voffB);
            PG8_WAIT_V(6); PG8_BAR; PG8_MMA(1, 1, At, B1); PG8_BAR;
            PG8_LDB(B0, 1, 0); PG8_SCHED; PG8_LDA(At, 1, 0); PG8_STAGE(PG8_SA(0, 1), a2 + hstepA, va1);
            PG8_WAIT_L(8); PG8_BAR; PG8_WAIT_L(0); PG8_MMA(0, 0, At, B0); PG8_BAR; PG8_SCHED;
            PG8_LDB(B1, 1, 1); PG8_STAGE(PG8_SB(1, 0), b3, voffB);
            PG8_BAR; PG8_WAIT_L(0); PG8_MMA(0, 1, At, B1); PG8_BAR;
            PG8_LDA(At, 1, 1); PG8_STAGE(PG8_SA(1, 0), a3, va0);
            PG8_BAR; PG8_WAIT_L(0); PG8_MMA(1, 0, At, B0); PG8_BAR; PG8_SCHED;
            PG8_STAGE(PG8_SB(1, 1), b3 + hstepB, voffB);
            PG8_WAIT_V(6); PG8_BAR; PG8_MMA(1, 1, At, B1); PG8_BAR;
        }
        E(acc, cur, wr, wc, fr, fq, !has_next);
        if (!has_next) break;
        E.init(acc, nxt, wr, wc, fr, fq);
        cur = nxt; nxt = nn; has_next = has_nn; cA = nA; cB = nB; ++ui;
#pragma unroll
        for (int h_ = 0; h_ < 2; ++h_)
#pragma unroll
            for (int i_ = 0; i_ < 2; ++i_) cva[h_][i_] = nva[h_][i_];
    }
    PG8_WAIT_V(0);
    if (wr == 0) PG8_BAR;
    PG8_BAR;
#undef PG8_GATHER
#undef PG8_ROWS
#undef PG8_SA
#undef PG8_SB
#undef PG8_STAGE
#undef PG8_LDA
#undef PG8_LDB
#undef PG8_MMA
#undef PG8_WAIT_V
#undef PG8_WAIT_L
#undef PG8_BAR
#undef PG8_SCHED
}
}

template <int NCOL>
__device__ __forceinline__ void proj_epi(const Ctx& C, int layer, int seg, int tok, f32x16 x1, f32x16 x2, int hi, char* wbuf, int srow, int scol) {
    const float* cs = WSP(float, WS_ROPE); const float* sn = cs + SEQ * 32;
    bool rms, rope; const float* g = C.in[12];
    if (layer == 0) { rms = (seg >= 8 && seg < 16) || seg == 32 || seg == 33; rope = seg < 24 || seg == 32 || seg == 33; g = C.in[12] + (seg < 16 ? 0 : 64); }
    else { rms = false; rope = seg < 8 || seg == 16 || seg == 17; }
    const float qs = seg < 16 ? C2 : 1.f;
    const int b = tok / SP, t = tok - b * SP;
    if (rms) {
        float ss = 0.f;
#pragma unroll
        for (int r = 0; r < 16; ++r) ss += x1[r] * x1[r] + x2[r] * x2[r];
        ss = swap_add(ss);
        const float rinv = rsqrtf(ss * (1.f / 64.f) + 1e-6f);
#pragma unroll
        for (int g4 = 0; g4 < 4; ++g4) {
            const f32x4 g1 = *(const f32x4*)(g + 8 * g4 + 4 * hi), g2 = *(const f32x4*)(g + 32 + 8 * g4 + 4 * hi);
#pragma unroll
            for (int i = 0; i < 4; ++i) { x1[4 * g4 + i] *= rinv * g1[i]; x2[4 * g4 + i] *= rinv * g2[i]; }
        }
    }
    if (rope && t < SEQ) {
#pragma unroll
        for (int g4 = 0; g4 < 4; ++g4) {
            const f32x4 cc = *(const f32x4*)(cs + t * 32 + 8 * g4 + 4 * hi), ssn = *(const f32x4*)(sn + t * 32 + 8 * g4 + 4 * hi);
#pragma unroll
            for (int i = 0; i < 4; ++i) { const float a = x1[4 * g4 + i], bb = x2[4 * g4 + i]; x1[4 * g4 + i] = a * cc[i] - bb * ssn[i]; x2[4 * g4 + i] = bb * cc[i] + a * ssn[i]; }
        }
    }
    if (layer == 0 && rope) {
        float n2 = 0.f;
#pragma unroll
        for (int r = 0; r < 16; ++r) n2 += x1[r] * x1[r] + x2[r] * x2[r];
        n2 = swap_add(n2) * (qs * qs);
#pragma unroll
        for (int m = 16; m >= 1; m >>= 1) n2 = fmaxf(n2, __shfl_xor(n2, m));
        if (C.lane == 0) atomicMax((unsigned*)(C.ws + WS_CTL) + CW_NORM + b * 36 + seg, __float_as_uint(n2));
    }
#pragma unroll
    for (int g4 = 0; g4 < 4; ++g4) {
        u32x2 o1, o2;
        o1.x = cvtpk(x1[4 * g4] * qs, x1[4 * g4 + 1] * qs); o1.y = cvtpk(x1[4 * g4 + 2] * qs, x1[4 * g4 + 3] * qs);
        o2.x = cvtpk(x2[4 * g4] * qs, x2[4 * g4 + 1] * qs); o2.y = cvtpk(x2[4 * g4 + 2] * qs, x2[4 * g4 + 3] * qs);
        stage_put<NCOL>(wbuf, srow, scol + 8 * g4 + 4 * hi, o1); stage_put<NCOL>(wbuf, srow, scol + 32 + 8 * g4 + 4 * hi, o2);
    }
}
template <int NMI>
__device__ __forceinline__ void proj_tile(const Ctx& C, int layer, int tt, int nt  ) {
    const int tid = C.tid, lane = C.lane, wid = C.wid, r32 = lane & 31, hi = lane >> 5, wn = wid >> 2, wt = wid & 3;
    const bf16_t* Wt = WSP(bf16_t, WS_WIN) + (size_t)layer * NQKV * D;
    const bf16_t* act = WSP(bf16_t, WS_ACT);
    const int c = GEMM_SRC_CHUNK(tid), r0 = tid >> 3;
    const bf16_t* rp[NMI + 4];
#pragma unroll
    for (int i = 0; i < NMI; ++i) rp[i] = Wt + (size_t)(nt * NMI * 64 + r0 + 64 * i) * D + c * 8;
#pragma unroll
    for (int i = 0; i < 4; ++i) rp[NMI + i] = act + (size_t)(tt * 256 + r0 + 64 * i) * D + c * 8;
    f32x16 acc[NMI][2];
    gemm_core<16, NMI>(C.lds, rp, acc, tid);
    char* wbuf = C.lds + wid * WStage<NMI * 32>::BYTES;
#pragma unroll
    for (int hd = 0; hd < NMI / 2; ++hd) {
        const int seg = ((nt * NMI * 64 + wn * NMI * 32) >> 6) + hd;
#pragma unroll
        for (int ti = 0; ti < 2; ++ti) proj_epi<NMI * 32>(C, layer, seg, tt * 256 + wt * 64 + ti * 32 + r32, acc[2 * hd][ti], acc[2 * hd + 1][ti], hi, wbuf, ti * 32 + r32, hd * 64);
    }
    stage_flush<NMI * 32>(wbuf, lane, WSP(bf16_t, WS_QKV) + (size_t)(tt * 256 + wt * 64) * NQKV + nt * NMI * 64 + wn * NMI * 32, NQKV, 64);
    __syncthreads();
}
struct ProjOrder { int vcu, nblk, full; __device__ __forceinline__ bool next(int i, pg8::Unit& u) const { const int w = i * nblk + vcu; if (w >= full) return false; u.pm = w / (NQKV / 256); u.pn = w % (NQKV / 256); return true; } };
struct EpiProj {
    static constexpr bool GATHER = false;
    static __device__ __forceinline__ size_t bstep(int K) { return (size_t)32 * K * 2; }
    static __device__ __forceinline__ int brow(int R) { return (R >> 5) * 64 + pg8::perm32(R & 31); }
    unsigned char* ws; const float* gn; int layer; const bf16_t* W;
    __device__ __forceinline__ const char* A(const pg8::Unit& u) const { return (const char*)(ws + WS_ACT) + (size_t)u.pm * (256 * D * 2); }
    __device__ __forceinline__ const char* B(const pg8::Unit& u) const { return (const char*)W + (size_t)u.pn * (256 * D * 2); }
    __device__ __forceinline__ void init(f32x4 (&acc)[2][2][4][2], const pg8::Unit&, int, int, int, int) const {
#pragma unroll
        for (int a = 0; a < 2; ++a)
#pragma unroll
            for (int b = 0; b < 2; ++b)
#pragma unroll
                for (int m = 0; m < 4; ++m)
#pragma unroll
                    for (int n = 0; n < 2; ++n) acc[a][b][m][n] = (f32x4){0.f, 0.f, 0.f, 0.f};
    }
    __device__ __forceinline__ void operator()(const f32x4 (&acc)[2][2][4][2], const pg8::Unit& u, int wr, int wc, int fr, int fq, bool wt) const {
        const int seg = u.pn * 4 + wc;
        const float* cs = (const float*)(ws + WS_ROPE); const float* sn = cs + SEQ * 32;
        bool rms, rope; const float* g = gn;
        if (layer == 0) { rms = (seg >= 8 && seg < 16) || seg == 32 || seg == 33; rope = seg < 24 || seg == 32 || seg == 33; g = gn + (seg < 16 ? 0 : 64); }
        else { rms = false; rope = seg < 8 || seg == 16 || seg == 17; }
        const float qs = seg < 16 ? C2 : 1.f;
        f32x4 g1a = {1, 1, 1, 1}, g1b = g1a, g2a = g1a, g2b = g1a;
        if (rms) { g1a = *(const f32x4*)(g + 8 * fq); g1b = *(const f32x4*)(g + 8 * fq + 4); g2a = *(const f32x4*)(g + 32 + 8 * fq); g2b = *(const f32x4*)(g + 32 + 8 * fq + 4); }
        bf16_t* qkv = (bf16_t*)(ws + WS_QKV);
        float nmax = 0.f;
#pragma unroll
        for (int ai = 0; ai < 2; ++ai)
#pragma unroll
            for (int m = 0; m < 4; ++m) {
                const int tok = u.pm * 256 + ai * 128 + wr * 64 + m * 16 + fr;
                const int b = tok / SP, t = tok - b * SP;
                f32x4 x1a = acc[ai][0][m][0], x1b = acc[ai][0][m][1], x2a = acc[ai][1][m][0], x2b = acc[ai][1][m][1];
                if (rms) {
                    float ss = 0.f;
#pragma unroll
                    for (int i = 0; i < 4; ++i) ss += x1a[i] * x1a[i] + x1b[i] * x1b[i] + x2a[i] * x2a[i] + x2b[i] * x2b[i];
                    ss += __shfl_xor(ss, 16); ss += __shfl_xor(ss, 32);
                    const float rinv = rsqrtf(ss * (1.f / 64.f) + 1e-6f);
                    x1a *= rinv * g1a; x1b *= rinv * g1b; x2a *= rinv * g2a; x2b *= rinv * g2b;
                }
                if (rope && t < SEQ) {
                    const f32x4 ca = *(const f32x4*)(cs + t * 32 + 8 * fq), cb = *(const f32x4*)(cs + t * 32 + 8 * fq + 4), sa = *(const f32x4*)(sn + t * 32 + 8 * fq), sb = *(const f32x4*)(sn + t * 32 + 8 * fq + 4);
                    const f32x4 y1a = x1a * ca - x2a * sa, y2a = x2a * ca + x1a * sa, y1b = x1b * cb - x2b * sb, y2b = x2b * cb + x1b * sb;
                    x1a = y1a; x2a = y2a; x1b = y1b; x2b = y2b;
                }
                if (layer == 0 && rope) {
                    float n2 = 0.f;
#pragma unroll
                    for (int i = 0; i < 4; ++i) n2 += x1a[i] * x1a[i] + x1b[i] * x1b[i] + x2a[i] * x2a[i] + x2b[i] * x2b[i];
                    n2 += __shfl_xor(n2, 16); n2 += __shfl_xor(n2, 32); nmax = fmaxf(nmax, n2);
                }
                u32x4 o1, o2;
                o1.x = cvtpk(x1a[0] * qs, x1a[1] * qs); o1.y = cvtpk(x1a[2] * qs, x1a[3] * qs); o1.z = cvtpk(x1b[0] * qs, x1b[1] * qs); o1.w = cvtpk(x1b[2] * qs, x1b[3] * qs);
                o2.x = cvtpk(x2a[0] * qs, x2a[1] * qs); o2.y = cvtpk(x2a[2] * qs, x2a[3] * qs); o2.z = cvtpk(x2b[0] * qs, x2b[1] * qs); o2.w = cvtpk(x2b[2] * qs, x2b[3] * qs);
                bf16_t* rowp = qkv + (size_t)tok * NQKV + seg * 64 + 8 * fq;
                st16_sel(rowp, o1, wt); st16_sel(rowp + 32, o2, wt);
            }
        if (layer == 0 && rope) {
            nmax *= qs * qs;
#pragma unroll
            for (int mk = 8; mk >= 1; mk >>= 1) nmax = fmaxf(nmax, __shfl_xor(nmax, mk));
            if ((fr | fq) == 0) atomicMax((unsigned*)(ws + WS_CTL) + CW_NORM + ((u.pm * 256) / SP) * 36 + seg, __float_as_uint(nmax));
        }
    }
};
__device__ __forceinline__ void phase_proj(const Ctx& C, int layer) {
    constexpr int NTT = R / 256, NNT = NQKV / 256, TOT = NTT * NNT;
    const int full = (TOT / C.nblk) * C.nblk;
    {
        ProjOrder S; S.vcu = C.vcu; S.nblk = C.nblk; S.full = full;
        EpiProj E; E.ws = C.ws; E.gn = C.in[12]; E.layer = layer; E.W = WSP(bf16_t, WS_WIN) + (size_t)layer * NQKV * D;
        pg8::gemm_phase((LAS unsigned char*)C.lds, D, S, E, C.tid);
    }
    for (int w2 = C.bid; w2 < 2 * (TOT - full); w2 += C.nblk) {
        const int w = full + (w2 >> 1);
        proj_tile<2>(C, layer, w / NNT, 2 * (w % NNT) + (w2 & 1));
    }
}

__device__ __forceinline__ void attn0_diff(const Ctx& C, int b, int hc, int q0, int kstart, int nt) {
    const attn128::bf16* qkv = (const attn128::bf16*)(WSP(bf16_t, WS_QKV) + (size_t)b * SP * NQKV);
    unsigned* nrm = (unsigned*)(C.ws + WS_CTL) + CW_NORM + b * 36;
    const float qn = sqrtf(__uint_as_float(__builtin_amdgcn_readfirstlane(xb_ld(&nrm[hc])))), kmaxs = sqrtf(__uint_as_float(__builtin_amdgcn_readfirstlane(xb_ld(&nrm[16 + hc])))) * 1.02f;
    if (qn * kmaxs < 60.f)
        attn128::attn_unit<8, true>(qkv + (size_t)q0 * NQKV + hc * 64, qkv + (size_t)kstart * NQKV + 1024 + hc * 64, qkv + (size_t)kstart * NQKV + 1536 + (hc >> 1) * 128,
                                    (attn128::bf16*)(WSP(bf16_t, WS_AO) + ((size_t)b * SP + q0) * D + hc * 128), NQKV, D, nt, C.lds, kmaxs);
    else
        attn128::attn_unit<8>(qkv + (size_t)q0 * NQKV + hc * 64, qkv + (size_t)kstart * NQKV + 1024 + hc * 64, qkv + (size_t)kstart * NQKV + 1536 + (hc >> 1) * 128,
                              (attn128::bf16*)(WSP(bf16_t, WS_AO) + ((size_t)b * SP + q0) * D + hc * 128), NQKV, D, nt, C.lds);
}
__device__ __forceinline__ void attn0_gqa(const Ctx& C, int b, int g, int q0, int kstart, int nt) {
    const attn_body::bf16* qkv = (const attn_body::bf16*)(WSP(bf16_t, WS_QKV) + (size_t)b * SP * NQKV);
    unsigned* nrm = (unsigned*)(C.ws + WS_CTL) + CW_NORM + b * 36;
    const float qn = sqrtf(__uint_as_float(__builtin_amdgcn_readfirstlane(xb_ld(&nrm[8 + g])))), kmaxs = sqrtf(__uint_as_float(__builtin_amdgcn_readfirstlane(xb_ld(&nrm[32 + (g >> 2)])))) * 1.02f;
    if (qn * kmaxs < 60.f)
        attn_body::attn_unit<8, true>(qkv + (size_t)q0 * NQKV + 512 + g * 64, qkv + (size_t)kstart * NQKV + 2048 + (g >> 2) * 64, qkv + (size_t)kstart * NQKV + 2176 + (g >> 2) * 64,
                                      (attn_body::bf16*)(WSP(bf16_t, WS_ACT) + ((size_t)b * SP + q0) * D + 512 + g * 64), NQKV, D, nt, C.lds, kmaxs);
    else
        attn_body::attn_unit<8>(qkv + (size_t)q0 * NQKV + 512 + g * 64, qkv + (size_t)kstart * NQKV + 2048 + (g >> 2) * 64, qkv + (size_t)kstart * NQKV + 2176 + (g >> 2) * 64,
                                (attn_body::bf16*)(WSP(bf16_t, WS_ACT) + ((size_t)b * SP + q0) * D + 512 + g * 64), NQKV, D, nt, C.lds);
}
__device__ __forceinline__ void phase_attn0(const Ctx& C) {
    if (C.nblk & 7) {
        conv_tiles<true, 0>(C, CONV_EARLY + C.bid, C.nblk, CONV_TILES); __syncthreads();
        for (int u = C.bid; u < 1024; u += C.nblk) { const int sl = (u >> 5) & 15; if (u < 512) attn0_diff(C, sl >> 3, sl & 7, (u & 31) * 256, 0, SP / 64); else attn0_gqa(C, sl >> 3, sl & 7, (u & 31) * 256, 0, SP / 64); }
        for (int u = C.bid; u < 32; u += C.nblk) { if (u < 16) attn0_diff(C, u >> 3, u & 7, SEQ, SEQ, NCTX / 64); else attn0_gqa(C, (u - 16) >> 3, (u - 16) & 7, SEQ, SEQ, NCTX / 64); }
        return;
    }
    const int xcd = C.vcu / (C.nblk >> 3), jx = C.vcu % (C.nblk >> 3);
    const int nper = C.nblk >> 3;
    if (nper != 32) { __syncthreads(); conv_tiles<true, 0>(C, CONV_EARLY + C.bid, C.nblk, CONV_TILES); __syncthreads(); }
    const int cslot = nper == 32 ? jx % 5 : -1;
#pragma nounroll
    for (int stp = 0; stp < 5; ++stp) {
        if (stp == cslot) { __syncthreads(); conv_tiles<true, (CONV_TILES - CONV_EARLY) / 256>(C, CONV_EARLY + C.bid, 256, CONV_TILES); __syncthreads(); }
        if (stp < 2) { for (int u = jx + stp * nper; u < 64; u += 2 * nper) { const int sl = xcd * 2 + (u >> 5); attn0_diff(C, sl >> 3, sl & 7, (u & 31) * 256, 0, SP / 64); } }
        else if (stp < 4) { for (int u = jx + (stp - 2) * nper; u < 64; u += 2 * nper) { const int sl = xcd * 2 + (u >> 5); attn0_gqa(C, sl >> 3, sl & 7, (u & 31) * 256, 0, SP / 64); } }
    }
    for (int u = C.bid; u < 32; u += C.nblk) { if (u < 16) attn0_diff(C, u >> 3, u & 7, SEQ, SEQ, NCTX / 64); else attn0_gqa(C, (u - 16) >> 3, (u - 16) & 7, SEQ, SEQ, NCTX / 64); }
}

__device__ __forceinline__ void phase_attn1(const Ctx& C) {
    const LAS float* rpbL = (const LAS float*)(LAS char*)(C.lds + attn_msk::ATTN_LDS_BYTES);
    for (int it = 0;; ++it) {
        const int u = __builtin_amdgcn_readfirstlane(xcd_item(C, it)); if (u >= 1024) break;
        const int kind = u >> 9, v = u & 511, b = v >> 8, g = (v >> 5) & 7, q0 = (v & 31) * 256;
        const attn_msk::bf16* qkv = (const attn_msk::bf16*)(WSP(bf16_t, WS_QKV) + (size_t)b * SP * NQKV);
        attn_msk::bf16* op = (attn_msk::bf16*)(WSP(bf16_t, WS_ACT) + ((size_t)b * SP + q0) * D);
        if (kind == 0) {
            const int lo = q0 - 128 < 0 ? 0 : q0 - 128, hi_ = q0 + 384 > SEQ ? SEQ : q0 + 384;
            attn_msk::attn_unit<8, 1>(qkv + (size_t)q0 * NQKV + g * 64, qkv + 1024 + (g >> 2) * 64, qkv + 1152 + (g >> 2) * 64, op + g * 64, NQKV, D, 4 + (hi_ - lo) / 64, C.lds,
                                      q0, lo, 0, C.in[15][g] * LOG2E, rpbL);
        } else {
            const int gr = q0 >> 6, R0 = gr - 4 < 0 ? 0 : (gr - 4 > 120 ? 120 : gr - 4);
            int R1 = gr + 3 - 4; R1 = (R1 < 0 ? 0 : (R1 > 120 ? 120 : R1)) + 8;
            const int nrows = R1 - R0;
            __syncthreads();
            { int t_ = C.tid; asm volatile("" : "+v"(t_)); if (t_ < 465) ((float*)(C.lds + attn_msk::ATTN_LDS_BYTES))[t_] = C.in[16][g * 465 + t_] * LOG2E; }
            __syncthreads();
            attn_msk::attn_unit<8, 2>(qkv + (size_t)q0 * NQKV + 512 + g * 64, qkv + 1280 + g * 64, qkv + 1792 + g * 64, op + 512 + g * 64, NQKV, D, 4 + nrows + (nrows & 1), C.lds,
                                      q0, R0 * 64, nrows, 0.f, rpbL);
        }
    }
}

__device__ __forceinline__ void phase_merge0(const Ctx& C) {
    const int lane = C.lane;
    const float* lv = C.in[10];
    const float sa = wave_sum(lv[lane] * lv[64 + lane]), sb = wave_sum(lv[128 + lane] * lv[192 + lane]);
    const float lam = expf(sa) - expf(sb) + 0.2f;
    const float g0 = C.in[11][2 * lane], g1 = C.in[11][2 * lane + 1];
    const bf16_t* ao = WSP(bf16_t, WS_AO); bf16_t* act = WSP(bf16_t, WS_ACT);
    for (int row = C.bid * 8 + C.wid; row < R; row += C.nblk * 8) {
#pragma unroll
        for (int h = 0; h < 4; ++h) {
            const unsigned a = *(const unsigned*)(ao + (size_t)row * D + (h * 2) * 128 + 2 * lane), b = *(const unsigned*)(ao + (size_t)row * D + (h * 2 + 1) * 128 + 2 * lane);
            const float d0 = bf2f((unsigned short)(a & 0xffff)) - lam * bf2f((unsigned short)(b & 0xffff)), d1 = bf2f((unsigned short)(a >> 16)) - lam * bf2f((unsigned short)(b >> 16));
            const float ss = wave_sum(d0 * d0 + d1 * d1);
            const float rinv = rsqrtf(ss * (1.f / 128.f) + 1e-6f) * 0.8f;
            *(unsigned*)(act + (size_t)row * D + h * 128 + 2 * lane) = cvtpk(d0 * rinv * g0, d1 * rinv * g1);
        }
    }
}

template <int NMI>
__device__ __forceinline__ void out_tile(const Ctx& C, int layer, int tt, int nt) {
    const int tid = C.tid, lane = C.lane, wid = C.wid, r32 = lane & 31, hi = lane >> 5, wn = wid >> 2, wt = wid & 3;
    const bf16_t* Wt = WSP(bf16_t, WS_WG) + (size_t)(layer * 3 + row_set(tt * 256)) * D * D;
    const bf16_t* act = WSP(bf16_t, WS_ACT);
    float* H = WSP(float, WS_H);
    const int c = GEMM_SRC_CHUNK(tid), r0 = tid >> 3;
    const bf16_t* rp[NMI + 4];
#pragma unroll
    for (int i = 0; i < NMI; ++i) rp[i] = Wt + (size_t)(nt * NMI * 64 + r0 + 64 * i) * D + c * 8;
#pragma unroll
    for (int i = 0; i < 4; ++i) rp[NMI + i] = act + (size_t)(tt * 256 + r0 + 64 * i) * D + c * 8;
    const int n0 = nt * NMI * 64 + wn * NMI * 32;
    f32x16 acc[NMI][2];
#pragma unroll
    for (int ti = 0; ti < 2; ++ti) {
        const int tok = tt * 256 + wt * 64 + ti * 32 + r32;
        const float* hp = (layer == 0 ? hin_row(C, tok) : H + (size_t)tok * D) + n0 + 4 * hi;
#pragma unroll
        for (int mi = 0; mi < NMI; ++mi)
#pragma unroll
            for (int g4 = 0; g4 < 4; ++g4) {
                const f32x4 hv = *(const f32x4*)(hp + mi * 32 + 8 * g4);
                acc[mi][ti][4 * g4] = hv[0]; acc[mi][ti][4 * g4 + 1] = hv[1]; acc[mi][ti][4 * g4 + 2] = hv[2]; acc[mi][ti][4 * g4 + 3] = hv[3];
            }
    }
    gemm_core<16, NMI, false, true>(C.lds, rp, acc, tid);
    constexpr int NC = NMI * 32, P = NC * 4 + 16, CH = NC / 4;
    char* wbuf = C.lds + wid * (32 * P);
#pragma unroll
    for (int ti = 0; ti < 2; ++ti) {
#pragma unroll
        for (int mi = 0; mi < NMI; ++mi)
#pragma unroll
            for (int g4 = 0; g4 < 4; ++g4) {
                f32x4 v; v[0] = ALPHA * acc[mi][ti][4 * g4]; v[1] = ALPHA * acc[mi][ti][4 * g4 + 1]; v[2] = ALPHA * acc[mi][ti][4 * g4 + 2]; v[3] = ALPHA * acc[mi][ti][4 * g4 + 3];
                *(f32x4*)(wbuf + r32 * P + (mi * 32 + 8 * g4 + 4 * hi) * 4) = v;
            }
        __builtin_amdgcn_sched_barrier(0);
#pragma unroll
        for (int i = 0; i < CH / 2; ++i) {
            if ((i & 3) == 0) __builtin_amdgcn_sched_barrier(0);
            const int idx = i * 64 + lane, row = idx / CH, ch = idx % CH;
            const int tok = tt * 256 + wt * 64 + ti * 32 + row;
            const u32x4 a = *(const u32x4*)(wbuf + row * P + ch * 16);
            st16_wt(H + (size_t)tok * D + n0 + ch * 4, a);
        }
        __builtin_amdgcn_sched_barrier(0);
    }
    __syncthreads();
}
struct OutOrder { int vcu, nblk, full, layer; __device__ __forceinline__ bool next(int i, pg8::Unit& u) const { const int w = i * nblk + vcu; if (w >= full) return false;
    int tt = w / (D / 256); if (layer != 0) tt = tt < 32 ? tt : tt + 1; u.pm = tt; u.pn = w % (D / 256); return true; } };
struct EpiOut {
    static constexpr bool GATHER = false;
    static __device__ __forceinline__ size_t bstep(int K) { return (size_t)128 * K * 2; }
    static __device__ __forceinline__ int brow(int R) { return R; }
    unsigned char* ws; const float* x; const float* cx; int layer;
    __device__ __forceinline__ const char* A(const pg8::Unit& u) const { return (const char*)(ws + WS_ACT) + (size_t)u.pm * (256 * D * 2); }
    __device__ __forceinline__ const char* B(const pg8::Unit& u) const { return (const char*)((const bf16_t*)(ws + WS_WG) + (size_t)(layer * 3 + row_set(u.pm * 256)) * D * D) + (size_t)u.pn * (256 * D * 2); }
    __device__ __forceinline__ const float* hrow(int row) const {
        if (layer != 0) return (const float*)(ws + WS_H) + (size_t)row * D;
        const int b = row / SP, t = row - b * SP;
        return t < SEQ ? x + ((size_t)b * SEQ + t) * D : cx + ((size_t)b * NCTX + (t - SEQ)) * D;
    }
    __device__ __forceinline__ void init(f32x4 (&acc)[2][2][4][2], const pg8::Unit& u, int wr, int wc, int fr, int fq) const {
#pragma unroll
        for (int ai = 0; ai < 2; ++ai)
#pragma unroll
            for (int m = 0; m < 4; ++m) { const float* hp = hrow(u.pm * 256 + ai * 128 + wr * 64 + m * 16 + fr) + u.pn * 256 + wc * 32 + 4 * fq;
#pragma unroll
                for (int bj = 0; bj < 2; ++bj)
#pragma unroll
                    for (int n = 0; n < 2; ++n) acc[ai][bj][m][n] = *(const f32x4*)(hp + bj * 128 + n * 16); }
    }
    __device__ __forceinline__ void operator()(const f32x4 (&acc)[2][2][4][2], const pg8::Unit& u, int wr, int wc, int fr, int fq, bool wt) const {
        float* H = (float*)(ws + WS_H);
#pragma unroll
        for (int ai = 0; ai < 2; ++ai)
#pragma unroll
            for (int m = 0; m < 4; ++m) { float* rowp = H + (size_t)(u.pm * 256 + ai * 128 + wr * 64 + m * 16 + fr) * D + u.pn * 256 + wc * 32 + 4 * fq;
#pragma unroll
                for (int bj = 0; bj < 2; ++bj)
#pragma unroll
                    for (int n = 0; n < 2; ++n) { const f32x4 o = ALPHA * acc[ai][bj][m][n]; st16_sel(rowp + bj * 128 + n * 16, __builtin_bit_cast(u32x4, o), wt); } }
    }
};
__device__ __forceinline__ void phase_out(const Ctx& C, int layer) {
    constexpr int NNT = D / 256;
    const int NTT = layer == 0 ? R / 256 : 2 * (SEQ / 256), TOT = NTT * NNT;
    const int full = (TOT / C.nblk) * C.nblk;
    {
        OutOrder S; S.vcu = C.vcu; S.nblk = C.nblk; S.full = full; S.layer = layer;
        EpiOut E; E.ws = C.ws; E.x = C.in[0]; E.cx = C.in[2]; E.layer = layer;
        pg8::gemm_phase((LAS unsigned char*)C.lds, D, S, E, C.tid);
    }
    for (int w2 = C.bid; w2 < 2 * (TOT - full); w2 += C.nblk) {
        const int w = full + (w2 >> 1);
        int tt = w / NNT; if (layer != 0) tt = tt < 32 ? tt : tt + 1;
        out_tile<2>(C, layer, tt, 2 * (w % NNT) + (w2 & 1));
    }
}

__device__ __forceinline__ int moe_row(int layer, int tok) { return layer == 0 ? tok : (tok >> 13) * SP + (tok & 8191); }
__device__ __forceinline__ void phase_route(const Ctx& C, int layer) {
    const int tid = C.tid, lane = C.lane, wid = C.wid;
    float* Wl = (float*)C.lds;
    int* se0 = (int*)(C.lds + 147456); int* se1 = se0 + 128; float* sw0 = (float*)(se1 + 128); float* sw1 = sw0 + 128;
    int* cnt = (int*)(sw1 + 128); int* base = cnt + 32; int* sl0 = base + 32; int* sl1 = sl0 + 128;
    float* smu = (float*)(sl1 + 128); float* srs = smu + 128;
    const float* wg = C.in[17] + (size_t)layer * D * 4; const float* wr = C.in[19] + (size_t)layer * D * 32;
    for (int i = tid; i < D * 9; i += NTHR) {
        const int k = i / 9, q = i - k * 9;
        const f32x4 v = q == 0 ? *(const f32x4*)(wg + k * 4) : *(const f32x4*)(wr + k * 32 + (q - 1) * 4);
        *(f32x4*)(Wl + (((k & 3) << 8) + (k >> 2)) * 36 + q * 4) = v;
    }
    const int T = layer == 0 ? R : NB * SEQ;
    const int chunk = (T + C.nblk - 1) / C.nblk;
    const int c0_ = C.bid * chunk, c1_ = c0_ + chunk < T ? c0_ + chunk : T;
  for (int t0 = c0_; t0 < c1_; t0 += 128) {
    const int t1 = t0 + 128 < c1_ ? t0 + 128 : c1_;
    __syncthreads();
    if (tid < 32) cnt[tid] = 0;
    __syncthreads();
    float* H = WSP(float, WS_H); bf16_t* act = WSP(bf16_t, WS_ACT);
    const float* lng = C.in[6] + (size_t)(layer * 2 + 0) * D; const float* lnb = C.in[7] + (size_t)(layer * 2 + 0) * D;
    const float* bg = C.in[18] + layer * 4; const float* br = C.in[20] + layer * 32;
    f32x4 xn[4];
    if (t0 + wid < t1) {
        const float* hn = H + (size_t)moe_row(layer, t0 + wid) * D;
#pragma unroll
        for (int i = 0; i < 4; ++i) xn[i] = *(const f32x4*)(hn + lane * 4 + 256 * i);
    }
    for (int tk = t0 + wid; tk < t1; tk += 8) {
        const int row = moe_row(layer, tk);
        const float* m = WSP(float, WS_MODS) + (size_t)(layer * 3 + row_set(row)) * 6144;
        float* hr = H + (size_t)row * D;
        f32x4 x[4]; float s = 0.f, q = 0.f;
#pragma unroll
        for (int i = 0; i < 4; ++i) { x[i] = xn[i]; s += (x[i][0] + x[i][1]) + (x[i][2] + x[i][3]); q += (x[i][0] * x[i][0] + x[i][1] * x[i][1]) + (x[i][2] * x[i][2] + x[i][3] * x[i][3]); }
        if (tk + 8 < t1) {
            const float* hn = H + (size_t)moe_row(layer, tk + 8) * D;
#pragma unroll
            for (int i = 0; i < 4; ++i) xn[i] = *(const f32x4*)(hn + lane * 4 + 256 * i);
        }
        wave_sum2(s, q, lane);
        const float mean = s * (1.f / 1024.f);
        const float rstd = rsqrtf(fmaxf(q * (1.f / 1024.f) - mean * mean, 0.f) + 1e-5f);
#pragma unroll
        for (int i = 0; i < 4; ++i) x[i] -= mean;
        f32x4 f[4]; u32x2 ob[4];
#pragma unroll
        for (int i = 0; i < 4; ++i) {
            const int col = lane * 4 + 256 * i;
            const f32x4 g = *(const f32x4*)(lng + col), bb = *(const f32x4*)(lnb + col);
            const f32x4 hv = x[i] * rstd * g + bb;
            const f32x4 sh = *(const f32x4*)(m + 3 * 1024 + col), sc = *(const f32x4*)(m + 4 * 1024 + col);
            f[i] = hv * (1.f + sc) + sh;
            ob[i].x = cvtpk(f[i][0], f[i][1]); ob[i].y = cvtpk(f[i][2], f[i][3]);
        }
        store_row_bf16(act + (size_t)row * D, lane, ob);
        f32x4 gl = {0, 0, 0, 0};
#pragma unroll
        for (int i = 0; i < 4; ++i)
#pragma unroll
            for (int cc = 0; cc < 4; ++cc) gl += f[i][cc] * *(const f32x4*)(Wl + (cc * 256 + 64 * i + lane) * 36);
        gl = wave_sum4(gl, lane);
        const float g0 = gl[0] + bg[0], g1 = gl[1] + bg[1], g2 = gl[2] + bg[2], g3 = gl[3] + bg[3];
        int gi = 0; float gm = g0;
        if (g1 > gm) { gm = g1; gi = 1; } if (g2 > gm) { gm = g2; gi = 2; } if (g3 > gm) { gm = g3; gi = 3; }
        const float gw = 1.f / (expf(g0 - gm) + expf(g1 - gm) + expf(g2 - gm) + expf(g3 - gm));
        f32x4 ea = {0, 0, 0, 0}, eb = ea;
#pragma unroll
        for (int i = 0; i < 4; ++i)
#pragma unroll
            for (int cc = 0; cc < 4; ++cc) {
                const float* wp = Wl + (cc * 256 + 64 * i + lane) * 36 + 4 + 8 * gi;
                ea += f[i][cc] * *(const f32x4*)(wp); eb += f[i][cc] * *(const f32x4*)(wp + 4);
            }
        float ev[8];
        wave_sum8(ea, eb, ev, lane);
#pragma unroll
        for (int k = 0; k < 8; ++k) ev[k] += br[gi * 8 + k];
        int i0 = 0; float v0 = ev[0];
#pragma unroll
        for (int k = 1; k < 8; ++k) if (ev[k] > v0) { v0 = ev[k]; i0 = k; }
        int i1 = -1; float v1 = -3.0e38f;
#pragma unroll
        for (int k = 0; k < 8; ++k) if (k != i0 && ev[k] > v1) { v1 = ev[k]; i1 = k; }
        const float e = expf(v1 - v0);
        if (lane == 0) { const int li = tk - t0; se0[li] = gi * 8 + i0; se1[li] = gi * 8 + i1; sw0[li] = gw / (1.f + e); sw1[li] = gw * e / (1.f + e); smu[li] = mean; srs[li] = rstd; }
    }
    __syncthreads();
    const int nloc = t1 - t0;
    if (tid < 2 * nloc) { const int li = tid >> 1; const int e = (tid & 1) ? se1[li] : se0[li]; const int s = atomicAdd(&cnt[e], 1); if (tid & 1) sl1[li] = s; else sl0[li] = s; }
    __syncthreads();
    unsigned* gc = (unsigned*)(C.ws + WS_CTL) + CW_CNT + layer * 64;
    if (tid < 32) base[tid] = cnt[tid] > 0 ? (int)atomicAdd(&gc[tid], (unsigned)cnt[tid]) : 0;
    __syncthreads();
    int* perm = WSP(int, WS_PERM); int* tokinfo = WSP(int, WS_TOK);
    if (tid < nloc) {
        const int li = tid, row = moe_row(layer, t0 + li);
        const int e0 = se0[li], e1 = se1[li], s0 = base[e0] + sl0[li], s1 = base[e1] + sl1[li];
        perm[e0 * CAP + s0] = row; perm[e1 * CAP + s1] = row;
        int* ti = tokinfo + (size_t)row * 8;
        ti[0] = e0; ti[1] = s0; ti[2] = e1; ti[3] = s1; ti[4] = __float_as_int(sw0[li]); ti[5] = __float_as_int(sw1[li]); ti[6] = __float_as_int(smu[li]); ti[7] = __float_as_int(srs[li]);
    }
  }
    __syncthreads();
}

struct MoeTab { int* cnt; int* off; int* tp; };
__device__ __forceinline__ MoeTab moe_tables(const Ctx& C, int layer, int ldsoff, bool build = true) {
    MoeTab M; M.cnt = (int*)(C.lds + ldsoff); M.off = M.cnt + 32; M.tp = M.off + 33;
    if (MK_SINGLE && !build) return M;
    __syncthreads();
    if (C.wid == 0) {
        const int lane = C.lane;
        unsigned* gc = (unsigned*)(C.ws + WS_CTL) + CW_CNT + layer * 64;
        const int c = lane < 32 ? (int)__hip_atomic_load(&gc[lane], __ATOMIC_RELAXED, __HIP_MEMORY_SCOPE_AGENT) : 0;
        const int tl = (c + 255) >> 8;
        int o = c, t = tl;
#pragma unroll
        for (int d = 1; d < 32; d <<= 1) { const int o2 = __shfl_up(o, d), t2 = __shfl_up(t, d); if (lane >= d) { o += o2; t += t2; } }
        if (lane < 32) { M.cnt[lane] = c; M.off[lane] = o - c; M.tp[lane] = t - tl; }
        if (lane == 31) { M.off[32] = o; M.tp[32] = t; }
    }
    __syncthreads();
    return M;
}

template <int NMI>
__device__ __forceinline__ void moe1_tile(const Ctx& C, int layer, const MoeTab& M, int ttile, int nt  ) {
    const int tid = C.tid, lane = C.lane, wid = C.wid, r32 = lane & 31, hi = lane >> 5, wn = wid >> 2, wt = wid & 3;
    const bf16_t* act = WSP(bf16_t, WS_ACT); const int* perm = WSP(int, WS_PERM);
    bf16_t* hb = WSP(bf16_t, WS_HB);
    const int c = GEMM_SRC_CHUNK(tid), r0 = tid >> 3;
    int e = 0;
    for (int k = 1; k < 32; ++k) if (M.tp[k] <= ttile) e = k;
    const int lt = ttile - M.tp[e], cnt = M.cnt[e];
    const bf16_t* rp[NMI + 4];
#pragma unroll
    for (int i = 0; i < NMI; ++i) {
        const int r = r0 + 64 * i, wn_ = r / (NMI * 32), mi = (r >> 5) % NMI, rr = r & 31;
        const bf16_t* Wb = (mi / (NMI / 2)) ? WSP(bf16_t, WS_W3) : WSP(bf16_t, WS_W1);
        rp[i] = Wb + ((size_t)(layer * 32 + e) * 512 + nt * (NMI * 32) + wn_ * (NMI * 16) + (mi % (NMI / 2)) * 32 + rr) * D + c * 8;
    }
#pragma unroll
    for (int i = 0; i < 4; ++i) {
        int slot = lt * 256 + r0 + 64 * i; slot = slot < cnt ? slot : cnt - 1;
        rp[NMI + i] = act + (size_t)perm[e * CAP + slot] * D + c * 8;
    }
    f32x16 acc[NMI][2];
    gemm_core<16, NMI, true>(C.lds, rp, acc, tid, cnt - lt * 256 < 256 ? cnt - lt * 256 : 256);
    char* wbuf = C.lds + wid * WStage<NMI * 16>::BYTES;
#pragma unroll
    for (int ti = 0; ti < 2; ++ti)
#pragma unroll
        for (int p = 0; p < NMI / 2; ++p)
#pragma unroll
            for (int g4 = 0; g4 < 4; ++g4) {
                float hv[4];
#pragma unroll
                for (int i = 0; i < 4; ++i) hv[i] = silu_f(acc[p][ti][4 * g4 + i]) * acc[p + NMI / 2][ti][4 * g4 + i];
                u32x2 o; o.x = cvtpk(hv[0], hv[1]); o.y = cvtpk(hv[2], hv[3]);
                stage_put<NMI * 16>(wbuf, ti * 32 + r32, p * 32 + 8 * g4 + 4 * hi, o);
            }
    stage_flush<NMI * 16>(wbuf, lane, hb + (size_t)(M.off[e] + lt * 256 + wt * 64) * 512 + nt * (NMI * 32) + wn * (NMI * 16), 512, cnt - (lt * 256 + wt * 64));
    __syncthreads();
}
struct MoeOrder { int vcu, nblk, full; const int* tp; const int* cnt; const int* off;
    __device__ __forceinline__ bool next(int i, pg8::Unit& u) const { const int w = i * nblk + vcu; if (w >= full) return false;
        const int tt = w >> 2; int e = 0;
        for (int k = 1; k < 32; ++k) if (tp[k] <= tt) e = k;
        e = __builtin_amdgcn_readfirstlane(e);
        u.pm = tt; u.pn = w & 3; u.e = e; u.lt = tt - __builtin_amdgcn_readfirstlane(tp[e]); u.cnt = __builtin_amdgcn_readfirstlane(cnt[e]); u.row0 = __builtin_amdgcn_readfirstlane(off[e]) + u.lt * 256; return true; } };
struct EpiMoe1 {
    static constexpr bool GATHER = true;
    static __device__ __forceinline__ size_t bstep(int) { return WS_W3 - WS_W1; }
    static __device__ __forceinline__ int brow(int R) { return (R & ~31) + pg8::perm32(R & 31); }
    unsigned char* ws; int layer;
    __device__ __forceinline__ const char* A(const pg8::Unit&) const { return (const char*)(ws + WS_ACT); }
    __device__ __forceinline__ int arow(const pg8::Unit& u, int r) const { int slot = u.lt * 256 + r; slot = slot < u.cnt ? slot : u.cnt - 1; return ((const int*)(ws + WS_PERM))[u.e * CAP + slot]; }
    __device__ __forceinline__ const char* B(const pg8::Unit& u) const { return (const char*)(ws + WS_W1) + ((size_t)(layer * 32 + u.e) * 512 + u.pn * 128) * (D * 2); }
    __device__ __forceinline__ void init(f32x4 (&acc)[2][2][4][2], const pg8::Unit&, int, int, int, int) const {
#pragma unroll
        for (int a = 0; a < 2; ++a)
#pragma unroll
            for (int b = 0; b < 2; ++b)
#pragma unroll
                for (int m = 0; m < 4; ++m)
#pragma unroll
                    for (int n = 0; n < 2; ++n) acc[a][b][m][n] = (f32x4){0.f, 0.f, 0.f, 0.f};
    }
    __device__ __forceinline__ void operator()(const f32x4 (&acc)[2][2][4][2], const pg8::Unit& u, int wr, int wc, int fr, int fq, bool wt) const {
        bf16_t* hb = (bf16_t*)(ws + WS_HB);
        const int nval = u.cnt - u.lt * 256;
#pragma unroll
        for (int ai = 0; ai < 2; ++ai)
#pragma unroll
            for (int m = 0; m < 4; ++m) { const int r = ai * 128 + wr * 64 + m * 16 + fr;
                if (r < nval) {
                    const f32x4 a0 = acc[ai][0][m][0], a1 = acc[ai][0][m][1], b0 = acc[ai][1][m][0], b1 = acc[ai][1][m][1];
                    u32x4 w; w.x = cvtpk(silu_f(a0[0]) * b0[0], silu_f(a0[1]) * b0[1]); w.y = cvtpk(silu_f(a0[2]) * b0[2], silu_f(a0[3]) * b0[3]);
                    w.z = cvtpk(silu_f(a1[0]) * b1[0], silu_f(a1[1]) * b1[1]); w.w = cvtpk(silu_f(a1[2]) * b1[2], silu_f(a1[3]) * b1[3]);
                    st16_sel(hb + (size_t)(u.row0 + r) * 512 + u.pn * 128 + wc * 32 + 8 * fq, w, wt); } }
    }
};
__device__ __forceinline__ void phase_moe1(const Ctx& C, int layer) {
    const MoeTab M = moe_tables(C, layer, GEMM_LDS);
    const int TOT = M.tp[32] * 4, full = (TOT / C.nblk) * C.nblk;
    {
        MoeOrder S; S.vcu = C.vcu; S.nblk = C.nblk; S.full = full; S.tp = M.tp; S.cnt = M.cnt; S.off = M.off;
        EpiMoe1 E; E.ws = C.ws; E.layer = layer;
        pg8::gemm_phase((LAS unsigned char*)C.lds, D, S, E, C.tid);
    }
    for (int w2 = C.vcu; w2 < 2 * (TOT - full); w2 += C.nblk) {
        const int w = full + (w2 >> 1);
        moe1_tile<2>(C, layer, M, w >> 2, 2 * (w & 3) + (w2 & 1));
    }
}

template <int NMI>
__device__ __forceinline__ void moe2_tile(const Ctx& C, int layer, const MoeTab& M, int ttile, int nt  ) {
    const int tid = C.tid, lane = C.lane, wid = C.wid, r32 = lane & 31, hi = lane >> 5, wn = wid >> 2, wt = wid & 3;
    const bf16_t* hb = WSP(bf16_t, WS_HB); bf16_t* yb = WSP(bf16_t, WS_YB);
    const int c = GEMM_SRC_CHUNK(tid), r0 = tid >> 3;
    int e = 0;
    for (int k = 1; k < 32; ++k) if (M.tp[k] <= ttile) e = k;
    const int lt = ttile - M.tp[e], cnt = M.cnt[e];
    const bf16_t* rp[NMI + 4];
#pragma unroll
    for (int i = 0; i < NMI; ++i) rp[i] = WSP(bf16_t, WS_W2) + ((size_t)(layer * 32 + e) * 1024 + nt * (NMI * 64) + r0 + 64 * i) * 512 + c * 8;
#pragma unroll
    for (int i = 0; i < 4; ++i) {
        int slot = lt * 256 + r0 + 64 * i; slot = slot < cnt ? slot : cnt - 1;
        rp[NMI + i] = hb + (size_t)(M.off[e] + slot) * 512 + c * 8;
    }
    f32x16 acc[NMI][2];
    gemm_core<8, NMI, true>(C.lds, rp, acc, tid, cnt - lt * 256 < 256 ? cnt - lt * 256 : 256);
    char* wbuf = C.lds + wid * WStage<NMI * 32>::BYTES;
#pragma unroll
    for (int ti = 0; ti < 2; ++ti)
#pragma unroll
        for (int mi = 0; mi < NMI; ++mi)
#pragma unroll
            for (int g4 = 0; g4 < 4; ++g4) {
                u32x2 o; o.x = cvtpk(acc[mi][ti][4 * g4], acc[mi][ti][4 * g4 + 1]); o.y = cvtpk(acc[mi][ti][4 * g4 + 2], acc[mi][ti][4 * g4 + 3]);
                stage_put<NMI * 32>(wbuf, ti * 32 + r32, mi * 32 + 8 * g4 + 4 * hi, o);
            }
    stage_flush<NMI * 32>(wbuf, lane, yb + (size_t)(M.off[e] + lt * 256 + wt * 64) * D + nt * (NMI * 64) + wn * (NMI * 32), D, cnt - (lt * 256 + wt * 64));
    __syncthreads();
}
struct EpiMoe2 {
    static constexpr bool GATHER = false;
    static __device__ __forceinline__ size_t bstep(int K) { return (size_t)128 * K * 2; }
    static __device__ __forceinline__ int brow(int R) { return (R & ~31) + pg8::perm32(R & 31); }
    unsigned char* ws; int layer;
    __device__ __forceinline__ const char* A(const pg8::Unit& u) const { return (const char*)(ws + WS_HB) + (size_t)u.row0 * (512 * 2); }
    __device__ __forceinline__ const char* B(const pg8::Unit& u) const { return (const char*)(ws + WS_W2) + ((size_t)(layer * 32 + u.e) * 1024 + u.pn * 256) * (512 * 2); }
    __device__ __forceinline__ void init(f32x4 (&acc)[2][2][4][2], const pg8::Unit&, int, int, int, int) const {
#pragma unroll
        for (int a = 0; a < 2; ++a)
#pragma unroll
            for (int b = 0; b < 2; ++b)
#pragma unroll
                for (int m = 0; m < 4; ++m)
#pragma unroll
                    for (int n = 0; n < 2; ++n) acc[a][b][m][n] = (f32x4){0.f, 0.f, 0.f, 0.f};
    }
    __device__ __forceinline__ void operator()(const f32x4 (&acc)[2][2][4][2], const pg8::Unit& u, int wr, int wc, int fr, int fq, bool wt) const {
        bf16_t* yb = (bf16_t*)(ws + WS_YB);
        const int nval = u.cnt - u.lt * 256;
#pragma unroll
        for (int ai = 0; ai < 2; ++ai)
#pragma unroll
            for (int m = 0; m < 4; ++m) { const int r = ai * 128 + wr * 64 + m * 16 + fr;
                if (r < nval) { bf16_t* rowp = yb + (size_t)(u.row0 + r) * D + u.pn * 256 + wc * 32 + 8 * fq;
#pragma unroll
                    for (int bj = 0; bj < 2; ++bj) { const f32x4 v0 = acc[ai][bj][m][0], v1 = acc[ai][bj][m][1];
                        u32x4 w; w.x = cvtpk(v0[0], v0[1]); w.y = cvtpk(v0[2], v0[3]); w.z = cvtpk(v1[0], v1[1]); w.w = cvtpk(v1[2], v1[3]);
                        st16_sel(rowp + bj * 128, w, wt); } } }
    }
};
__device__ __forceinline__ void phase_moe2(const Ctx& C, int layer) {
    const MoeTab M = moe_tables(C, layer, GEMM_LDS, false);
    const int TOT = M.tp[32] * 4, full = (TOT / C.nblk) * C.nblk;
    {
        MoeOrder S; S.vcu = C.vcu; S.nblk = C.nblk; S.full = full; S.tp = M.tp; S.cnt = M.cnt; S.off = M.off;
        EpiMoe2 E; E.ws = C.ws; E.layer = layer;
        pg8::gemm_phase((LAS unsigned char*)C.lds, 512, S, E, C.tid);
    }
    for (int w2 = C.vcu; w2 < 2 * (TOT - full); w2 += C.nblk) {
        const int w = full + (w2 >> 1);
        moe2_tile<2>(C, layer, M, w >> 2, 2 * (w & 3) + (w2 & 1));
    }
}

__device__ __forceinline__ void phase_final(const Ctx& C, int layer) {
    const int lane = C.lane;
    const MoeTab M = moe_tables(C, layer, GEMM_LDS, false);
    float* H = WSP(float, WS_H); const bf16_t* yb = WSP(bf16_t, WS_YB); const int* tokinfo = WSP(int, WS_TOK);
    bf16_t* act = WSP(bf16_t, WS_ACT);
    const float* lng = C.in[6] + (size_t)(layer * 2 + 1) * D; const float* lnb = C.in[7] + (size_t)(layer * 2 + 1) * D;
    const float* lng1 = C.in[6] + (size_t)(layer * 2 + 0) * D; const float* lnb1 = C.in[7] + (size_t)(layer * 2 + 0) * D;
    const int T = layer == 0 ? R : NB * SEQ;
    for (int tk = C.bid * 8 + C.wid; tk < T; tk += C.nblk * 8) {
        const int row = moe_row(layer, tk), set = row_set(row);
        const int* ti = tokinfo + (size_t)row * 8;
        const int e0 = ti[0], s0 = ti[1], e1 = ti[2], s1 = ti[3]; const float w0 = __int_as_float(ti[4]), w1 = __int_as_float(ti[5]);
        const float mu1 = __int_as_float(ti[6]), rs1 = __int_as_float(ti[7]);
        const bf16_t* y0 = yb + (size_t)(M.off[e0] + s0) * D; const bf16_t* y1 = yb + (size_t)(M.off[e1] + s1) * D;
        const float* m = WSP(float, WS_MODS) + (size_t)(layer * 3 + set) * 6144;
        float* hr = H + (size_t)row * D;
        f32x4 x[4]; float s = 0.f, q = 0.f;
#pragma unroll
        for (int i = 0; i < 4; ++i) {
            const int col = lane * 4 + 256 * i;
            const f32x4 hv = (*(const f32x4*)(hr + col) - mu1) * rs1 * *(const f32x4*)(lng1 + col) + *(const f32x4*)(lnb1 + col), g5 = *(const f32x4*)(m + 5 * 1024 + col);
            const u32x2 a = *(const u32x2*)(y0 + col), b = *(const u32x2*)(y1 + col);
            f32x4 y;
            y[0] = w0 * bf2f((unsigned short)(a.x & 0xffff)) + w1 * bf2f((unsigned short)(b.x & 0xffff)); y[1] = w0 * bf2f((unsigned short)(a.x >> 16)) + w1 * bf2f((unsigned short)(b.x >> 16));
            y[2] = w0 * bf2f((unsigned short)(a.y & 0xffff)) + w1 * bf2f((unsigned short)(b.y & 0xffff)); y[3] = w0 * bf2f((unsigned short)(a.y >> 16)) + w1 * bf2f((unsigned short)(b.y >> 16));
            x[i] = ALPHA * hv + g5 * y;
            s += (x[i][0] + x[i][1]) + (x[i][2] + x[i][3]); q += (x[i][0] * x[i][0] + x[i][1] * x[i][1]) + (x[i][2] * x[i][2] + x[i][3] * x[i][3]);
        }
        wave_sum2(s, q, lane);
        const float mean = s * (1.f / 1024.f);
        const float rstd = rsqrtf(fmaxf(q * (1.f / 1024.f) - mean * mean, 0.f) + 1e-5f);
#pragma unroll
        for (int i = 0; i < 4; ++i) x[i] -= mean;
        const float* mn = WSP(float, WS_MODS) + (size_t)(3 + set) * 6144;
        u32x2 ob[4];
#pragma unroll
        for (int i = 0; i < 4; ++i) {
            const int col = lane * 4 + 256 * i;
            const f32x4 g = *(const f32x4*)(lng + col), bb = *(const f32x4*)(lnb + col);
            const f32x4 hv = x[i] * rstd * g + bb;
            if (layer == 0) {
                st16_wt(hr + col, __builtin_bit_cast(u32x4, hv));
                const f32x4 sh = *(const f32x4*)(mn + col), sc = *(const f32x4*)(mn + 1024 + col);
                const f32x4 a = hv * (1.f + sc) + sh;
                ob[i].x = cvtpk(a[0], a[1]); ob[i].y = cvtpk(a[2], a[3]);
            } else {
                *(f32x4*)(C.out + (size_t)tk * D + col) = hv;
            }
        }
        if (layer == 0) store_row_bf16(act + (size_t)row * D, lane, ob);
    }
}

constexpr int NPHASE = 17;
#ifndef REPEAT_PH
#define REPEAT_PH -1
#endif
#define PH_REP(k) ((k) == REPEAT_PH)
#ifndef PH_ONLY
#define PH_EN(k) true
#else
#define PH_EN(k) ((k) == PH_ONLY)
#endif
__global__ void __launch_bounds__(NTHR, 2) mega(Args args) {
    extern __shared__ __attribute__((aligned(16))) char lds[];
    Ctx CB; CB.lds = lds; CB.tid = threadIdx.x; CB.lane = CB.tid & 63; CB.wid = __builtin_amdgcn_readfirstlane(CB.tid >> 6);
    CB.bid = blockIdx.x; CB.nblk = gridDim.x; CB.vcu = blockIdx.x; CB.in = args.in; CB.out = args.out; CB.ws = args.ws;
    const Ctx& C = CB;
    volatile LAS unsigned* bst = (volatile LAS unsigned*)(LAS char*)(lds + LDS_BYTES - 64);
    if (CB.tid < 4) bst[CB.tid] = 0u;
    __syncthreads();
#if MK_SINGLE
    constexpr bool single = true;
#else
    const bool single = (args.ph_hi - args.ph_lo) > 1;
#endif
    XcdBarrier bar; bar.bar = (unsigned*)(C.ws + WS_CTL) + CW_BAR; bar.x = 0; bar.st = bst;
    if (single) bar = xcd_barrier_post((unsigned*)(C.ws + WS_CTL) + CW_BAR, bst);
#if MK_SINGLE
    constexpr int lo = 0, hi = NPHASE;
#else
    const int lo = args.ph_lo, hi = args.ph_hi;
#endif
#define RUN(k, call) if (lo <= (k) && (k) < hi) { Ctx C = CB; asm volatile("" : "+v"(C.tid)); C.lane = C.tid & 63; C.wid = __builtin_amdgcn_readfirstlane(C.tid >> 6); if (PH_EN(k)) { call; } if (PH_REP(k)) { __syncthreads(); call; } if (single && (k) + 1 < hi) xcd_barrier(bar); else __syncthreads(); }
    RUN(0, phase_prologue(C))
    if (single && lo == 0) {
        if (CB.tid == 0) {
            unsigned base = 0;
            for (unsigned j = 0; j < 16; ++j) { const unsigned c = xb_ld(&bar.bar[XB_XCNT(j)]); if (j < bar.x) base += c; }
            bst[3] = base + bst[2];
        }
        __syncthreads();
        const unsigned v = bst[3];
        CB.vcu = __builtin_amdgcn_readfirstlane(v < (unsigned)CB.nblk ? (int)v : CB.bid);
    }
    RUN(1, phase_mod0(C))
    RUN(2, phase_proj(C, 0))
    RUN(3, phase_attn0(C))
    RUN(4, phase_merge0(C))
    RUN(5, phase_out(C, 0))
    RUN(6, phase_route(C, 0))
    RUN(7, phase_moe1(C, 0))
    RUN(8, phase_moe2(C, 0))
    RUN(9, phase_final(C, 0))
    RUN(10, phase_proj(C, 1))
    RUN(11, phase_attn1(C))
    RUN(12, phase_out(C, 1))
    RUN(13, phase_route(C, 1))
    RUN(14, phase_moe1(C, 1))
    RUN(15, phase_moe2(C, 1))
    RUN(16, phase_final(C, 1))
#undef RUN
}

extern "C" void kernel_launch(void* const* d_in, const int* in_sizes, int n_in, void* d_out, int out_size, void* d_ws, size_t ws_size, hipStream_t stream) {
    static int grid = 0;
    if (grid == 0) {
        if (n_in != 24 || ws_size < WS_END) { fprintf(stderr, "kernel_launch: unexpected n_in %d / ws_size %zu (need %zu)\n", n_in, ws_size, (size_t)WS_END); grid = -1; return; }
        int dev = 0, cus = 0, per_cu = 0;
        hipGetDevice(&dev);
        hipDeviceGetAttribute(&cus, hipDeviceAttributeMultiprocessorCount, dev);
        hipFuncSetAttribute((const void*)mega, hipFuncAttributeMaxDynamicSharedMemorySize, LDS_BYTES);
        hipOccupancyMaxActiveBlocksPerMultiprocessor(&per_cu, (const void*)mega, NTHR, LDS_BYTES);
        (void)hipGetLastError();
        if (per_cu < 1) fprintf(stderr, "kernel_launch: occupancy query says %d blocks/CU\n", per_cu);
        grid = cus;
    }
    if (grid < 0) return;
    hipMemsetAsync((char*)d_ws + WS_CTL, 0, CTL_BYTES, stream);
    Args a{};
    for (int i = 0; i < 24; ++i) a.in[i] = (const float*)d_in[i];
    a.out = (float*)d_out; a.ws = (unsigned char*)d_ws;
#if MK_SINGLE
    a.ph_lo = 0; a.ph_hi = NPHASE;
    void* kargs[] = {&a};
    hipLaunchCooperativeKernel((const void*)mega, dim3(grid), dim3(NTHR), kargs, LDS_BYTES, stream);
#else
    for (int ph = 0; ph < NPHASE; ++ph) {
        a.ph_lo = ph; a.ph_hi = ph + 1;
        hipLaunchKernelGGL(mega, dim3(grid), dim3(NTHR), LDS_BYTES, stream, a);
    }
#endif
}
```

```cpp
#include <hip/hip_runtime.h>
#include <stdint.h>
#include <stdio.h>

#ifndef MK_SINGLE
#define MK_SINGLE 1
#endif

typedef unsigned short bf16_t;
typedef short bf16x8 __attribute__((ext_vector_type(8)));
typedef short s16x4 __attribute__((ext_vector_type(4)));
typedef short v4i16_t __attribute__((ext_vector_type(4)));
typedef float f32x16 __attribute__((ext_vector_type(16)));
typedef float f32x4 __attribute__((ext_vector_type(4)));
typedef float f32x2 __attribute__((ext_vector_type(2)));
typedef __bf16 bf16x2_t __attribute__((ext_vector_type(2)));
typedef unsigned u32x4 __attribute__((ext_vector_type(4)));
typedef unsigned u32x2 __attribute__((ext_vector_type(2)));
#define LAS __attribute__((address_space(3)))

constexpr int D = 1024, NB = 2, SEQ = 8192, NCTX = 256, SP = SEQ + NCTX  , R = NB * SP  ;
constexpr int NQKV = 2304, NTHR = 512, CAP = R;
constexpr float ALPHA = 1.4142135623730951f;
constexpr float LOG2E = 1.4426950408889634f;
constexpr float C2 = 0.125f * LOG2E;
constexpr float NEGBIG = -1e30f;

constexpr size_t MiB = 1u << 20;
constexpr size_t WS_CTL = 0, CTL_BYTES = 1 * MiB;
constexpr size_t WS_MODS = 1 * MiB;
constexpr size_t WS_ROPE = 2 * MiB;
constexpr size_t WS_WIN = 4 * MiB;
constexpr size_t WS_WOUT = 13 * MiB;
constexpr size_t WS_W1 = 18 * MiB;
constexpr size_t WS_W3 = 82 * MiB;
constexpr size_t WS_W2 = 146 * MiB;
constexpr size_t WS_ACT = 210 * MiB;
constexpr size_t WS_H = 243 * MiB;
constexpr size_t WS_QKV = 309 * MiB;
constexpr size_t WS_AO = 384 * MiB;
constexpr size_t WS_TOK = 417 * MiB;
constexpr size_t WS_PERM = 418 * MiB;
constexpr size_t WS_HB = 309 * MiB;
constexpr size_t WS_YB = 343 * MiB;
constexpr size_t WS_WG = 421 * MiB;
constexpr size_t WS_END = 433 * MiB;
constexpr int CW_BAR = 4096, CW_CNT = 16384;

constexpr int LDS_BYTES = 155648;

__device__ __forceinline__ unsigned cvtpk(float lo, float hi) { f32x2 v = {lo, hi}; bf16x2_t b = __builtin_convertvector(v, bf16x2_t); return __builtin_bit_cast(unsigned, b); }
__device__ __forceinline__ bf16_t f2bf(float f) { unsigned u = __builtin_bit_cast(unsigned, f); return (bf16_t)((u + 0x7fffu + ((u >> 16) & 1u)) >> 16); }
__device__ __forceinline__ float bf2f(unsigned short h) { return __builtin_bit_cast(float, (unsigned)h << 16); }
__device__ __forceinline__ int crow(int r, int hi) { return (r & 3) + 8 * (r >> 2) + 4 * hi; }
__device__ __forceinline__ float wave_sum(float v) {
#pragma unroll
    for (int o = 1; o < 64; o <<= 1) v += __shfl_xor(v, o);
    return v;
}
__device__ __forceinline__ float rdlane(float v, int l) { return __int_as_float(__builtin_amdgcn_readlane(__float_as_int(v), l)); }
__device__ __forceinline__ void wave_sum2(float& a, float& b, int lane) {
    const bool b0 = lane & 1;
    float k = b0 ? b : a; const float sd = b0 ? a : b;
    k += __shfl_xor(sd, 1);
#pragma unroll
    for (int o = 2; o < 64; o <<= 1) k += __shfl_xor(k, o);
    a = rdlane(k, 0); b = rdlane(k, 1);
}
__device__ __forceinline__ f32x4 wave_sum4(f32x4 v, int lane) {
    const bool b0 = lane & 1, b1 = lane & 2;
    float k0 = b0 ? v[2] : v[0], k1 = b0 ? v[3] : v[1]; const float s0 = b0 ? v[0] : v[2], s1 = b0 ? v[1] : v[3];
    k0 += __shfl_xor(s0, 1); k1 += __shfl_xor(s1, 1);
    float k = b1 ? k1 : k0; const float sd = b1 ? k0 : k1;
    k += __shfl_xor(sd, 2);
#pragma unroll
    for (int o = 4; o < 64; o <<= 1) k += __shfl_xor(k, o);
    f32x4 r; r[0] = rdlane(k, 0); r[1] = rdlane(k, 2); r[2] = rdlane(k, 1); r[3] = rdlane(k, 3);
    return r;
}
__device__ __forceinline__ void wave_sum8(f32x4 lo, f32x4 hi_, float (&out)[8], int lane) {
    const bool b0 = lane & 1, b1 = lane & 2, b2 = lane & 4;
    f32x4 k = b0 ? hi_ : lo; const f32x4 sd = b0 ? lo : hi_;
#pragma unroll
    for (int i = 0; i < 4; ++i) k[i] += __shfl_xor(sd[i], 1);
    float k0 = b1 ? k[2] : k[0], k1 = b1 ? k[3] : k[1]; const float s0 = b1 ? k[0] : k[2], s1 = b1 ? k[1] : k[3];
    k0 += __shfl_xor(s0, 2); k1 += __shfl_xor(s1, 2);
    float kk = b2 ? k1 : k0; const float s2 = b2 ? k0 : k1;
    kk += __shfl_xor(s2, 4);
#pragma unroll
    for (int o = 8; o < 64; o <<= 1) kk += __shfl_xor(kk, o);
#pragma unroll
    for (int j = 0; j < 8; ++j) out[j] = rdlane(kk, (j >> 2) + 2 * ((j >> 1) & 1) + 4 * (j & 1));
}
__device__ __forceinline__ float swap_add(float v) { auto rr = __builtin_amdgcn_permlane32_swap(__float_as_uint(v), __float_as_uint(v), false, false); return __uint_as_float(rr[0]) + __uint_as_float(rr[1]); }
__device__ __forceinline__ float swap_max(float v) { auto rr = __builtin_amdgcn_permlane32_swap(__float_as_uint(v), __float_as_uint(v), false, false); return fmaxf(__uint_as_float(rr[0]), __uint_as_float(rr[1])); }
__device__ __forceinline__ f32x16 mfma32(bf16x8 a, bf16x8 b, f32x16 c) { return __builtin_amdgcn_mfma_f32_32x32x16_bf16(a, b, c, 0, 0, 0); }
__device__ __forceinline__ float silu_f(float x) { return x * __builtin_amdgcn_rcpf(1.f + __builtin_amdgcn_exp2f(x * -1.4426950408889634f)); }

#define XB_TMO      128
#define XB_XCNT(j)  (256  + 64 * (j))
#define XB_XSUB(j)  (1280 + 64 * (j))
#define XB_XGEN(j)  (2304 + 64 * (j))
#define XB_TOP      3328
#define XB_TOPGEN   3392
#define XCD_BAR_WORDS 3456
#define XB_SPIN_CAP (1u << 20)
__device__ __forceinline__ unsigned xb_ld(unsigned* p)              { return __hip_atomic_load(p, __ATOMIC_RELAXED, __HIP_MEMORY_SCOPE_AGENT); }
__device__ __forceinline__ unsigned xb_add(unsigned* p, unsigned v) { return __hip_atomic_fetch_add(p, v, __ATOMIC_RELAXED, __HIP_MEMORY_SCOPE_AGENT); }
__device__ __forceinline__ unsigned xb_xcc_id() { return (unsigned)__builtin_amdgcn_s_getreg((3 << 11) | 20) & 0xFu; }
#define XB_SPIN(cond, bar) do { unsigned _sp = 0; while (cond) { __builtin_amdgcn_s_sleep(1); \
    if ((++_sp & 255u) == 0u) { if (xb_ld(&(bar)[XB_TMO])) break; if (_sp > XB_SPIN_CAP) { atomicAdd(&(bar)[XB_TMO], 1u); break; } } } } while (0)
struct XcdBarrier { unsigned* bar; unsigned x; volatile LAS unsigned* st; };
__device__ __forceinline__ XcdBarrier xcd_barrier_post(unsigned* bar, volatile LAS unsigned* st) {
    XcdBarrier b; b.bar = bar; b.x = xb_xcc_id(); b.st = st;
    if (threadIdx.x == 0) st[2] = xb_add(&bar[XB_XCNT(b.x)], 1u);
    return b;
}
__device__ __forceinline__ void xcd_barrier_complete(unsigned* bar, unsigned x, unsigned& nloc, unsigned& nx) {
    const unsigned G = gridDim.x * gridDim.y * gridDim.z;
    unsigned sum, cnt, mine, sp = 0u;
    for (;;) {
        sum = 0u; cnt = 0u; mine = 0u;
#pragma unroll
        for (unsigned j = 0; j < 16; ++j) { const unsigned c = xb_ld(&bar[XB_XCNT(j)]); sum += c; cnt += (c > 0u) ? 1u : 0u; mine = (j == x) ? c : mine; }
        if (sum == G) break;
        __builtin_amdgcn_s_sleep(1);
        if ((++sp & 255u) == 0u) { if (xb_ld(&bar[XB_TMO])) break; if (sp > XB_SPIN_CAP) { atomicAdd(&bar[XB_TMO], 1u); break; } }
    }
    nloc = mine > 0u ? mine : 1u; nx = cnt > 0u ? cnt : 1u;
}
__device__ __forceinline__ void xcd_barrier(const XcdBarrier& b) {
    asm volatile("s_waitcnt vmcnt(0)" ::: "memory");
    __syncthreads();
    if (threadIdx.x == 0) {
        unsigned* bar = b.bar;
        __builtin_amdgcn_s_waitcnt(0);
        unsigned nloc = b.st[0], nx = b.st[1];
        if (nloc == 0u) { xcd_barrier_complete(bar, b.x, nloc, nx); b.st[0] = nloc; b.st[1] = nx; }
        const unsigned old = xb_add(&bar[XB_XSUB(b.x)], 1u);
        const unsigned gen = old / nloc;
        if (old + 1u == (gen + 1u) * nloc) {
            __builtin_amdgcn_fence(__ATOMIC_RELEASE, "agent");
            asm volatile("s_waitcnt vmcnt(0)" ::: "memory");
            const unsigned og = xb_add(&bar[XB_TOP], 1u);
            const unsigned tg = og / nx;
            asm volatile("buffer_inv sc1" ::: "memory");
            if (og + 1u == (tg + 1u) * nx) xb_add(&bar[XB_TOPGEN], 1u);
            else XB_SPIN(xb_ld(&bar[XB_TOPGEN]) == tg, bar);
            xb_add(&bar[XB_XGEN(b.x)], 1u);
            asm volatile("s_waitcnt vmcnt(0)" ::: "memory");
        } else {
            asm volatile("buffer_inv sc1" ::: "memory");
            XB_SPIN(xb_ld(&bar[XB_XGEN(b.x)]) == gen, bar);
            asm volatile("s_waitcnt vmcnt(0)" ::: "memory");
        }
    }
    __syncthreads();
}

__device__ __forceinline__ void st16_wt(void* p, u32x4 v) { asm volatile("global_store_dwordx4 %0, %1, off sc1\n\ts_nop 1" :: "v"(p), "v"(v) : "memory"); }
#define ATTN_STORE16(p,v) st16_wt((void*)(p), (v))
#include <hip/hip_bf16.h>
#include <cmath>
namespace attn_body {
using bf16=__hip_bfloat16;
using bf16x8=__attribute__((ext_vector_type(8)))short;
using s16x4=__attribute__((ext_vector_type(4)))short;
using f32x16=__attribute__((ext_vector_type(16)))float;
using u32x4=__attribute__((ext_vector_type(4)))unsigned;
constexpr int D=64;
constexpr int NW=8,QBLK=32,QB=QBLK*NW,KVBLK=64;
__device__ __forceinline__ int crow(int r,int hi){return (r&3)+8*(r>>2)+4*hi;}
#define SBAR() __builtin_amdgcn_sched_barrier(0)
constexpr int NSLOT=3, SLOTB=8192;
constexpr int LDS_K=0, LDS_V=NSLOT*SLOTB, LDS_WS=2*NSLOT*SLOTB, LDS_OST=LDS_WS+NW*64*4, LDS_BYTES=LDS_OST+NW*4096;
constexpr float C2=0.125f*1.4426950408889634f;
__device__ __forceinline__ void glds16(const void*gsrc,unsigned lds_dst){unsigned keep;
  asm volatile("s_mov_b32 %0, m0\n\ts_mov_b32 m0, %2\n\ts_nop 0\n\tglobal_load_lds_dwordx4 %1, off\n\ts_mov_b32 m0, %0":"=&s"(keep):"v"(gsrc),"s"(lds_dst):"memory");}
__device__ __forceinline__ float max3f(float a,float b,float c){float r;asm("v_max3_f32 %0, %1, %2, %3":"=v"(r):"v"(a),"v"(b),"v"(c));return r;}
__device__ __forceinline__ float max2f(float a,float b){float r;asm("v_max_f32_e32 %0, %1, %2":"=v"(r):"v"(a),"v"(b));return r;}
__device__ __forceinline__ float fadd_s(float a,float b){float r;asm("v_add_f32_e32 %0, %1, %2":"=v"(r):"v"(a),"v"(b));return r;}
__device__ __forceinline__ float fsub_s(float a,float b){float r;asm("v_sub_f32_e32 %0, %1, %2":"=v"(r):"v"(a),"v"(b));return r;}
typedef float f32x2_t __attribute__((ext_vector_type(2))); typedef __bf16 bf16x2_t __attribute__((ext_vector_type(2)));
__device__ __forceinline__ unsigned cvtpk_s(float lo,float hi){f32x2_t v={lo,hi};bf16x2_t b=__builtin_convertvector(v,bf16x2_t);return __builtin_bit_cast(unsigned,b);}
#define WAIT_BAR(N) asm volatile("s_waitcnt vmcnt(" #N ") lgkmcnt(0)\n\ts_barrier":::"memory")

__device__ __forceinline__ void qkt(f32x16&p0,f32x16&p1,const char*Kslot,const bf16x8*qr,const f32x16&negm,int r32,int hi){
  const char*kb=Kslot+hi*1024+r32*16;
  #pragma unroll
  for(int d0=0;d0<4;++d0){
    const bf16x8 b0=*reinterpret_cast<const bf16x8*>(kb+d0*2048);
    const bf16x8 b1=*reinterpret_cast<const bf16x8*>(kb+d0*2048+512);
    if(d0==0){p0=__builtin_amdgcn_mfma_f32_32x32x16_bf16(b0,qr[0],negm,0,0,0);p1=__builtin_amdgcn_mfma_f32_32x32x16_bf16(b1,qr[0],negm,0,0,0);}
    else{p0=__builtin_amdgcn_mfma_f32_32x32x16_bf16(b0,qr[d0],p0,0,0,0);p1=__builtin_amdgcn_mfma_f32_32x32x16_bf16(b1,qr[d0],p1,0,0,0);}}
}
typedef __attribute__((address_space(3))) const char* lds_cptr;
typedef short v4i16_t __attribute__((ext_vector_type(4)));
__device__ __forceinline__ void kload8(bf16x8*kf,lds_cptr kp){
  kf[0]=*(const __attribute__((address_space(3))) bf16x8*)(kp);      kf[1]=*(const __attribute__((address_space(3))) bf16x8*)(kp+512);
  kf[2]=*(const __attribute__((address_space(3))) bf16x8*)(kp+2048); kf[3]=*(const __attribute__((address_space(3))) bf16x8*)(kp+2560);
  kf[4]=*(const __attribute__((address_space(3))) bf16x8*)(kp+4096); kf[5]=*(const __attribute__((address_space(3))) bf16x8*)(kp+4608);
  kf[6]=*(const __attribute__((address_space(3))) bf16x8*)(kp+6144); kf[7]=*(const __attribute__((address_space(3))) bf16x8*)(kp+6656);
}
__device__ __forceinline__ void kload2(bf16x8*kf,lds_cptr kp,int j){ kf[2*j]=*(const __attribute__((address_space(3))) bf16x8*)(kp+j*2048); kf[2*j+1]=*(const __attribute__((address_space(3))) bf16x8*)(kp+j*2048+512); }
__device__ __forceinline__ s16x4 vtr(lds_cptr p){ return __builtin_bit_cast(s16x4,__builtin_amdgcn_ds_read_tr16_b64_v4i16((__attribute__((address_space(3))) v4i16_t*)p)); }
__device__ __forceinline__ float rowmax(const f32x16&p0,const f32x16&p1){
  float a=max3f(p0[0],p0[1],p1[0]),b=max3f(p0[2],p0[3],p1[1]);a=max3f(a,p1[2],p1[3]);
  #pragma unroll
  for(int r=4;r<16;r+=4){a=max3f(a,p0[r],p0[r+1]);b=max3f(b,p0[r+2],p0[r+3]);a=max3f(a,p1[r],p1[r+1]);b=max3f(b,p1[r+2],p1[r+3]);}
  const float m=max2f(a,b);
  auto rr=__builtin_amdgcn_permlane32_swap(__float_as_uint(m),__float_as_uint(m),false,false);
  return max2f(__uint_as_float(rr[0]),__uint_as_float(rr[1]));
}
__device__ __forceinline__ void pv(f32x16*o,int vb,bf16x8 pa0,bf16x8 pa1,bf16x8 pa2,bf16x8 pa3){
  #pragma unroll
  for(int d0=0;d0<2;++d0){s16x4 lo[4],hi[4];
    #pragma unroll
    for(int ks=0;ks<4;++ks){
      asm volatile("ds_read_b64_tr_b16 %0,%1 offset:%c2":"=&v"(lo[ks]):"v"(vb),"i"(d0*4096+ks*1024):"memory");
      asm volatile("ds_read_b64_tr_b16 %0,%1 offset:%c2":"=&v"(hi[ks]):"v"(vb),"i"(d0*4096+ks*1024+512):"memory");}
    asm volatile("s_waitcnt lgkmcnt(0)":::"memory");SBAR();
    #define PK(k) (bf16x8){lo[k][0],lo[k][1],lo[k][2],lo[k][3],hi[k][0],hi[k][1],hi[k][2],hi[k][3]}
    o[d0]=__builtin_amdgcn_mfma_f32_32x32x16_bf16(pa0,PK(0),o[d0],0,0,0);
    o[d0]=__builtin_amdgcn_mfma_f32_32x32x16_bf16(pa1,PK(1),o[d0],0,0,0);
    o[d0]=__builtin_amdgcn_mfma_f32_32x32x16_bf16(pa2,PK(2),o[d0],0,0,0);
    o[d0]=__builtin_amdgcn_mfma_f32_32x32x16_bf16(pa3,PK(3),o[d0],0,0,0);
    #undef PK
  }
}

#ifndef ATTN_STORE16
#define ATTN_STORE16(p,v) (*(u32x4*)(p)=(v))
#endif
template<int THRL,bool FIXEDM=false> __device__ __forceinline__ void attn_unit(const bf16*Qu,const bf16*__restrict__ Kh,const bf16*__restrict__ Vh,bf16*Ou,const int DM,const int OP,const int NT,char*shm,const float kmaxs=0.f){
  int tid=threadIdx.x; asm volatile("":"+v"(tid));
  const int lane=tid&63,r32=lane&31,hi=lane>>5; const int wid=__builtin_amdgcn_readfirstlane(tid>>6);
  const bf16*Qw=Qu+(long)(wid*QBLK)*DM;
  const unsigned lds0=(unsigned)(uintptr_t)shm;
  float*wsf=(float*)(shm+LDS_WS)+wid*64;
  const bf16*ksrc=Kh+(long)lane*DM+wid*8;
  const bf16*vsrc=Vh+(long)(16*(wid&3)+(lane>>2))*DM+(wid>>2)*32+(lane&3)*8;
  const unsigned kdst=lds0+LDS_K+wid*1024, vdst=lds0+LDS_V+wid*1024;
  #define DMA_K(t,slot) glds16(ksrc+(long)(t)*KVBLK*DM,(unsigned)__builtin_amdgcn_readfirstlane(kdst+(slot)))
  #define DMA_V(t,slot) glds16(vsrc+(long)(t)*KVBLK*DM,(unsigned)__builtin_amdgcn_readfirstlane(vdst+(slot)))
  const int vb0=(int)(lds0+LDS_V)+((lane>>4)&1)*32+(lane&3)*8+(4*hi+((lane&15)>>2))*64;
  const char*Kbase=shm+LDS_K; bf16x8 kf[8];
  const lds_cptr shm3=(lds_cptr)shm; const lds_cptr kp0=shm3+LDS_K+hi*1024+r32*16; const lds_cptr vp0=shm3+LDS_V+((lane>>4)&1)*32+(lane&3)*8+(4*hi+((lane&15)>>2))*64;
  if(wid>=4)__builtin_amdgcn_s_setprio(1);
  DMA_K(0,0);DMA_V(0,0);DMA_K(1,SLOTB);
  bf16x8 qr[4];
  #pragma unroll
  for(int d0=0;d0<4;++d0)qr[d0]=*reinterpret_cast<const bf16x8*>(&Qw[(long)r32*DM+d0*16+hi*8]);
  float mb=0.f;
  if constexpr(FIXEDM){ float q2=0.f;
    _Pragma("unroll") for(int d0=0;d0<4;++d0){ const u32x4 w_=__builtin_bit_cast(u32x4,qr[d0]);
      _Pragma("unroll") for(int e=0;e<4;++e){ const float lo_=__uint_as_float(w_[e]<<16),hi_=__uint_as_float(w_[e]&0xffff0000u); q2+=lo_*lo_+hi_*hi_; } }
    { auto rr=__builtin_amdgcn_permlane32_swap(__float_as_uint(q2),__float_as_uint(q2),false,false); q2=__uint_as_float(rr[0])+__uint_as_float(rr[1]); }
    mb=__builtin_sqrtf(q2)*kmaxs; }
  float mhat=0.f,l_reg=0.f;f32x16 o[2];o[0]=f32x16{};o[1]=f32x16{};f32x16 negm=f32x16{};asm volatile("":"+v"(negm));
  #define CMASK(P0,P1,t) do{}while(0)
  bool resc=false;
  #define START(P0,P1) do{ const float rm=FIXEDM?mb:rowmax(P0,P1); resc=false; \
    { const float dl=rm; mhat=fadd_s(mhat,dl); \
      _Pragma("unroll") for(int r=0;r<16;++r){P0[r]=fsub_s(P0[r],dl);P1[r]=fsub_s(P1[r],dl);} \
      _Pragma("unroll") for(int r=0;r<16;++r)negm[r]=-mhat; asm volatile("":"+v"(negm)); } \
    _Pragma("unroll") for(int r=0;r<16;++r)P0[r]=__builtin_amdgcn_exp2f(P0[r]); }while(0)
  #define RESC() do{ if(resc){ asm volatile("s_waitcnt lgkmcnt(0)":::"memory"); \
      _Pragma("unroll") for(int d_=0;d_<2;++d_) _Pragma("unroll") for(int r=0;r<16;++r)o[d_][r]*=wsf[crow(r,hi)]; } }while(0)
  f32x16 pA0,pA1,pB0,pB1;
  int sl_prev=0,sl_cur=0,sl_next=SLOTB;
  #define ROT() do{sl_prev=sl_cur;sl_cur=sl_next;sl_next=(sl_next==(NSLOT-1)*SLOTB)?0:sl_next+SLOTB;}while(0)
  DMA_K(2,2*SLOTB);
  WAIT_BAR(3);
  qkt(pA0,pA1,Kbase,qr,negm,r32,hi);asm volatile("s_nop 15\n\ts_nop 7":"+v"(pA0),"+v"(pA1));CMASK(pA0,pA1,0);
  START(pA0,pA1);
  _Pragma("unroll") for(int r=0;r<16;++r)pA1[r]=__builtin_amdgcn_exp2f(pA1[r]);
  WAIT_BAR(0);
  DMA_K(3,0);DMA_V(1,SLOTB);
  ROT();
  kload8(kf,kp0+sl_cur);
  WAIT_BAR(2);
  s16x4 vlo[8],vhi[8]; u32x4 pw0,pw1,pw2,pw3;
  #define PKW(P,B) cvtpk_s(P[B],P[B+1])
  #define PAF(k) __builtin_bit_cast(bf16x8,pw##k)
  #define VFR(i) (bf16x8){vlo[i][0],vlo[i][1],vlo[i][2],vlo[i][3],vhi[i][0],vhi[i][1],vhi[i][2],vhi[i][3]}
  #define PIN(x) asm volatile("":"+v"(x))
  #define MX3(a,b,c) __builtin_fmaxf(__builtin_fmaxf((a),(b)),(c))
  #define GAPA(MF,A0,A1,A2,A3,W0,W1,PW) do{ MF; sacc+=A0; sacc+=A1; sacc+=A2; sacc+=A3; PIN(sacc); W0; W1; PIN(PW); SBAR(); }while(0)
  #define EX(v) __builtin_amdgcn_exp2f(v)
  #define GAPB(MF,X,B) do{ MF; X[B]=EX(X[B]); X[B+1]=EX(X[B+1]); X[B+2]=EX(X[B+2]); X[B+3]=EX(X[B+3]); PIN(X); SBAR(); }while(0)
  #define VRD(i) do{ vlo[i]=vtr(vp_+(((i)>>2)*4096+((i)&3)*1024)); vhi[i]=vtr(vp_+(((i)>>2)*4096+((i)&3)*1024+512)); }while(0)
  #define KRD(G,j) do{ if(G){ kload2(kf,kp0+sl_next,j); SBAR(); } }while(0)
  #define STEP(C0,C1,P0,P1,t,GK,GV,GL) do{ SBAR(); \
    const lds_cptr vp_=vp0+sl_prev; \
    VRD(0); SBAR(); float sacc=(P0[0]+P0[1]); \
    GAPA(C0=__builtin_amdgcn_mfma_f32_32x32x16_bf16(kf[0],qr[0],negm,0,0,0), P0[2],P0[3],P0[4],P0[5],     pw0[0]=PKW(P0,0), pw0[1]=PKW(P0,2), pw0); \
    VRD(4); SBAR(); GAPA(C1=__builtin_amdgcn_mfma_f32_32x32x16_bf16(kf[1],qr[0],negm,0,0,0), P0[6],P0[7],P0[8],P0[9],     pw0[2]=PKW(P0,4), pw0[3]=PKW(P0,6), pw0); \
    VRD(1); SBAR(); GAPA(C0=__builtin_amdgcn_mfma_f32_32x32x16_bf16(kf[2],qr[1],C0,0,0,0),   P0[10],P0[11],P0[12],P0[13], pw1[0]=PKW(P0,8), pw1[1]=PKW(P0,10), pw1); \
    VRD(5); SBAR(); GAPA(C1=__builtin_amdgcn_mfma_f32_32x32x16_bf16(kf[3],qr[1],C1,0,0,0),   P0[14],P0[15],P1[0],P1[1],   pw1[2]=PKW(P0,12),pw1[3]=PKW(P0,14), pw1); \
    VRD(2); SBAR(); GAPA(C0=__builtin_amdgcn_mfma_f32_32x32x16_bf16(kf[4],qr[2],C0,0,0,0),   P1[2],P1[3],P1[4],P1[5],     pw2[0]=PKW(P1,0), pw2[1]=PKW(P1,2), pw2); \
    VRD(6); SBAR(); GAPA(C1=__builtin_amdgcn_mfma_f32_32x32x16_bf16(kf[5],qr[2],C1,0,0,0),   P1[6],P1[7],P1[8],P1[9],     pw2[2]=PKW(P1,4), pw2[3]=PKW(P1,6), pw2); \
    VRD(3); SBAR(); GAPA(C0=__builtin_amdgcn_mfma_f32_32x32x16_bf16(kf[6],qr[3],C0,0,0,0),   P1[10],P1[11],P1[12],P1[13], pw3[0]=PKW(P1,8), pw3[1]=PKW(P1,10), pw3); \
    VRD(7); SBAR(); GAPA(C1=__builtin_amdgcn_mfma_f32_32x32x16_bf16(kf[7],qr[3],C1,0,0,0),   P1[14],P1[15],0.f,0.f,       pw3[2]=PKW(P1,12),pw3[3]=PKW(P1,14), pw3); \
    l_reg+=sacc; \
    if(GK){DMA_K((t)+3,sl_cur);} if(GV){DMA_V((t)+1,sl_next);} \
    CMASK(C0,C1,t); \
    if constexpr(!FIXEDM){ float a=MX3(C0[0],C0[1],C1[0]),b=MX3(C0[2],C0[3],C1[1]); a=MX3(a,C1[2],C1[3]); \
      _Pragma("unroll") for(int r=4;r<16;r+=4){a=MX3(a,C0[r],C0[r+1]);b=MX3(b,C0[r+2],C0[r+3]);a=MX3(a,C1[r],C1[r+1]);b=MX3(b,C1[r+2],C1[r+3]);} \
      float rm=__builtin_fmaxf(a,b); { auto rr=__builtin_amdgcn_permlane32_swap(__float_as_uint(rm),__float_as_uint(rm),false,false); rm=__builtin_fmaxf(__uint_as_float(rr[0]),__uint_as_float(rr[1])); } \
      resc=false; \
      if(__builtin_expect(__any(rm>(float)THRL),0)){ const float dl=__builtin_fmaxf(rm,0.f); mhat+=dl; \
        _Pragma("unroll") for(int r=0;r<16;++r){C0[r]-=dl;C1[r]-=dl;} \
        _Pragma("unroll") for(int r=0;r<16;++r)negm[r]=-mhat; asm volatile("":"+v"(negm)); \
        const float f=__builtin_amdgcn_exp2f(-dl); l_reg*=f; if(hi==0)wsf[r32]=f; resc=true; } } \
    SBAR(); \
    GAPB(o[0]=__builtin_amdgcn_mfma_f32_32x32x16_bf16(PAF(0),VFR(0),o[0],0,0,0), C0,0); \
    GAPB(o[1]=__builtin_amdgcn_mfma_f32_32x32x16_bf16(PAF(0),VFR(4),o[1],0,0,0), C0,4); \
    KRD(GL,0); GAPB(o[0]=__builtin_amdgcn_mfma_f32_32x32x16_bf16(PAF(1),VFR(1),o[0],0,0,0), C0,8); \
    KRD(GL,1); GAPB(o[1]=__builtin_amdgcn_mfma_f32_32x32x16_bf16(PAF(1),VFR(5),o[1],0,0,0), C0,12); \
    KRD(GL,2); GAPB(o[0]=__builtin_amdgcn_mfma_f32_32x32x16_bf16(PAF(2),VFR(2),o[0],0,0,0), C1,0); \
    KRD(GL,3); GAPB(o[1]=__builtin_amdgcn_mfma_f32_32x32x16_bf16(PAF(2),VFR(6),o[1],0,0,0), C1,4); \
    GAPB(o[0]=__builtin_amdgcn_mfma_f32_32x32x16_bf16(PAF(3),VFR(3),o[0],0,0,0), C1,8); \
    GAPB(o[1]=__builtin_amdgcn_mfma_f32_32x32x16_bf16(PAF(3),VFR(7),o[1],0,0,0), C1,12); \
    }while(0)
  int t=1;
  for(;t+5<NT;t+=2){
    STEP(pB0,pB1,pA0,pA1,t,true,true,true);     WAIT_BAR(2); RESC(); ROT();
    STEP(pA0,pA1,pB0,pB1,t+1,true,true,true);   WAIT_BAR(2); RESC(); ROT();
  }
  #define ENDW(tt) do{ if((tt)+3<NT){WAIT_BAR(2);} else if((tt)+2<NT){WAIT_BAR(1);} else {WAIT_BAR(0);} }while(0)
  for(;t+1<NT;t+=2){
    STEP(pB0,pB1,pA0,pA1,t,(t+3<NT),(t+1<NT),(t+1<NT));       ENDW(t);   RESC(); ROT();
    STEP(pA0,pA1,pB0,pB1,t+1,(t+4<NT),(t+2<NT),(t+2<NT));     ENDW(t+1); RESC(); ROT();
  }
  STEP(pB0,pB1,pA0,pA1,NT-1,false,false,false); RESC();
  { float sacc=pB0[0]+pB0[1]; _Pragma("unroll") for(int r=2;r<16;++r)sacc+=pB0[r]; _Pragma("unroll") for(int r=0;r<16;++r)sacc+=pB1[r]; l_reg+=sacc;
    pw0=(u32x4){PKW(pB0,0),PKW(pB0,2),PKW(pB0,4),PKW(pB0,6)};pw1=(u32x4){PKW(pB0,8),PKW(pB0,10),PKW(pB0,12),PKW(pB0,14)};pw2=(u32x4){PKW(pB1,0),PKW(pB1,2),PKW(pB1,4),PKW(pB1,6)};pw3=(u32x4){PKW(pB1,8),PKW(pB1,10),PKW(pB1,12),PKW(pB1,14)};
    SBAR(); pv(o,vb0+sl_cur,PAF(0),PAF(1),PAF(2),PAF(3)); }
  #undef PKW
  #undef PAF
  #undef VFR
  #undef PIN
  #undef MX3
  #undef GAPA
  #undef GAPB
  #undef EX
  #undef VRD
  #undef KRD
  #undef STEP
  #undef ENDW
  {auto rr=__builtin_amdgcn_permlane32_swap(__float_as_uint(l_reg),__float_as_uint(l_reg),false,false);l_reg=__uint_as_float(rr[0])+__uint_as_float(rr[1]);}
  if(hi==0)wsf[32+r32]=l_reg;asm volatile("s_waitcnt lgkmcnt(0)":::"memory");
  float rli[16];
  #pragma unroll
  for(int r=0;r<16;++r)rli[r]=__builtin_amdgcn_rcpf(wsf[32+crow(r,hi)]);
  bf16*Ow=Ou+(long)(wid*QBLK)*OP;
  { bf16*stg=(bf16*)(shm+LDS_OST)+wid*2048;
    #pragma unroll
    for(int r=0;r<16;++r){const int orow=crow(r,hi);
      #pragma unroll
      for(int d0=0;d0<2;++d0)stg[orow*64+d0*32+r32]=__float2bfloat16(o[d0][r]*rli[r]);}
    asm volatile("s_waitcnt lgkmcnt(0)":::"memory");
    #pragma unroll
    for(int i=0;i<4;++i){const int row=i*8+(lane>>3),ch=lane&7; const u32x4 v=*(const u32x4*)(stg+row*64+ch*8); ATTN_STORE16(Ow+(long)row*OP+ch*8,v);} }
  asm volatile("s_waitcnt lgkmcnt(0)\n\ts_barrier":::"memory");
  if(wid>=4)__builtin_amdgcn_s_setprio(0);
  #undef DMA_K
  #undef DMA_V
  #undef CMASK
  #undef START
  #undef RESC
  #undef ROT
}
constexpr int ATTN_LDS_BYTES=LDS_BYTES;
}

namespace attn128 {
using bf16=__hip_bfloat16;
using bf16x8=__attribute__((ext_vector_type(8)))short;
using s16x4=__attribute__((ext_vector_type(4)))short;
using f32x16=__attribute__((ext_vector_type(16)))float;
using u32x4=__attribute__((ext_vector_type(4)))unsigned;
constexpr int D=64;
constexpr int NW=8,QBLK=32,QB=QBLK*NW,KVBLK=64;
__device__ __forceinline__ int crow(int r,int hi){return (r&3)+8*(r>>2)+4*hi;}
#define SBAR() __builtin_amdgcn_sched_barrier(0)
constexpr int NSLOT=3, SLOTB=8192;
constexpr int KSLOTS=4, LDS_K=0, LDS_V=KSLOTS*SLOTB, LDS_WS=LDS_V+2*NSLOT*SLOTB, LDS_OST=LDS_WS+NW*64*4, LDS_BYTES=LDS_OST+NW*8192;
constexpr float C2=0.125f*1.4426950408889634f;
__device__ __forceinline__ void glds16(const void*gsrc,unsigned lds_dst){unsigned keep;
  asm volatile("s_mov_b32 %0, m0\n\ts_mov_b32 m0, %2\n\ts_nop 0\n\tglobal_load_lds_dwordx4 %1, off\n\ts_mov_b32 m0, %0":"=&s"(keep):"v"(gsrc),"s"(lds_dst):"memory");}
__device__ __forceinline__ void glds16s(const void*gbase_,unsigned voff,unsigned lds_dst){unsigned keep;
  const unsigned long long gb_=(unsigned long long)(uintptr_t)gbase_; const unsigned long long gbase=((unsigned long long)(unsigned)__builtin_amdgcn_readfirstlane((int)(gb_>>32))<<32)|(unsigned)__builtin_amdgcn_readfirstlane((int)gb_);
  asm volatile("s_mov_b32 %0, m0\n\ts_mov_b32 m0, %3\n\ts_nop 0\n\tglobal_load_lds_dwordx4 %1, %2\n\ts_mov_b32 m0, %0":"=&s"(keep):"v"(voff),"s"(gbase),"s"(lds_dst):"memory");}
__device__ __forceinline__ float max3f(float a,float b,float c){float r;asm("v_max3_f32 %0, %1, %2, %3":"=v"(r):"v"(a),"v"(b),"v"(c));return r;}
__device__ __forceinline__ float max2f(float a,float b){float r;asm("v_max_f32_e32 %0, %1, %2":"=v"(r):"v"(a),"v"(b));return r;}
__device__ __forceinline__ float fadd_s(float a,float b){float r;asm("v_add_f32_e32 %0, %1, %2":"=v"(r):"v"(a),"v"(b));return r;}
__device__ __forceinline__ float fsub_s(float a,float b){float r;asm("v_sub_f32_e32 %0, %1, %2":"=v"(r):"v"(a),"v"(b));return r;}
typedef float f32x2_t __attribute__((ext_vector_type(2))); typedef __bf16 bf16x2_t __attribute__((ext_vector_type(2)));
__device__ __forceinline__ unsigned cvtpk_s(float lo,float hi){f32x2_t v={lo,hi};bf16x2_t b=__builtin_convertvector(v,bf16x2_t);return __builtin_bit_cast(unsigned,b);}
#define WAIT_BAR(N) asm volatile("s_waitcnt vmcnt(" #N ") lgkmcnt(0)\n\ts_barrier":::"memory")

__device__ __forceinline__ void qkt(f32x16&p0,f32x16&p1,const char*Kslot,const bf16x8*qr,const f32x16&negm,int r32,int hi){
  const char*kb=Kslot+hi*1024+r32*16;
  #pragma unroll
  for(int d0=0;d0<4;++d0){
    const bf16x8 b0=*reinterpret_cast<const bf16x8*>(kb+d0*2048);
    const bf16x8 b1=*reinterpret_cast<const bf16x8*>(kb+d0*2048+512);
    if(d0==0){p0=__builtin_amdgcn_mfma_f32_32x32x16_bf16(b0,qr[0],negm,0,0,0);p1=__builtin_amdgcn_mfma_f32_32x32x16_bf16(b1,qr[0],negm,0,0,0);}
    else{p0=__builtin_amdgcn_mfma_f32_32x32x16_bf16(b0,qr[d0],p0,0,0,0);p1=__builtin_amdgcn_mfma_f32_32x32x16_bf16(b1,qr[d0],p1,0,0,0);}}
}
typedef __attribute__((address_space(3))) const char* lds_cptr;
typedef short v4i16_t __attribute__((ext_vector_type(4)));
__device__ __forceinline__ void kload8(bf16x8*kf,lds_cptr kp){
  kf[0]=*(const __attribute__((address_space(3))) bf16x8*)(kp);      kf[1]=*(const __attribute__((address_space(3))) bf16x8*)(kp+512);
  kf[2]=*(const __attribute__((address_space(3))) bf16x8*)(kp+2048); kf[3]=*(const __attribute__((address_space(3))) bf16x8*)(kp+2560);
  kf[4]=*(const __attribute__((address_space(3))) bf16x8*)(kp+4096); kf[5]=*(const __attribute__((address_space(3))) bf16x8*)(kp+4608);
  kf[6]=*(const __attribute__((address_space(3))) bf16x8*)(kp+6144); kf[7]=*(const __attribute__((address_space(3))) bf16x8*)(kp+6656);
}
__device__ __forceinline__ void kload2(bf16x8*kf,lds_cptr kp,int j){ kf[2*j]=*(const __attribute__((address_space(3))) bf16x8*)(kp+j*2048); kf[2*j+1]=*(const __attribute__((address_space(3))) bf16x8*)(kp+j*2048+512); }
__device__ __forceinline__ s16x4 vtr(lds_cptr p){ return __builtin_bit_cast(s16x4,__builtin_amdgcn_ds_read_tr16_b64_v4i16((__attribute__((address_space(3))) v4i16_t*)p)); }
__device__ __forceinline__ float rowmax(const f32x16&p0,const f32x16&p1){
  float a=max3f(p0[0],p0[1],p1[0]),b=max3f(p0[2],p0[3],p1[1]);a=max3f(a,p1[2],p1[3]);
  #pragma unroll
  for(int r=4;r<16;r+=4){a=max3f(a,p0[r],p0[r+1]);b=max3f(b,p0[r+2],p0[r+3]);a=max3f(a,p1[r],p1[r+1]);b=max3f(b,p1[r+2],p1[r+3]);}
  const float m=max2f(a,b);
  auto rr=__builtin_amdgcn_permlane32_swap(__float_as_uint(m),__float_as_uint(m),false,false);
  return max2f(__uint_as_float(rr[0]),__uint_as_float(rr[1]));
}
__device__ __forceinline__ void pv(f32x16*o,int vb,bf16x8 pa0,bf16x8 pa1,bf16x8 pa2,bf16x8 pa3){
  #pragma unroll
  for(int d0=0;d0<4;++d0){s16x4 lo[4],hi[4];
    #pragma unroll
    for(int ks=0;ks<4;++ks){
      asm volatile("ds_read_b64_tr_b16 %0,%1 offset:%c2":"=&v"(lo[ks]):"v"(vb),"i"(d0*4096+ks*1024):"memory");
      asm volatile("ds_read_b64_tr_b16 %0,%1 offset:%c2":"=&v"(hi[ks]):"v"(vb),"i"(d0*4096+ks*1024+512):"memory");}
    asm volatile("s_waitcnt lgkmcnt(0)":::"memory");SBAR();
    #define PK(k) (bf16x8){lo[k][0],lo[k][1],lo[k][2],lo[k][3],hi[k][0],hi[k][1],hi[k][2],hi[k][3]}
    o[d0]=__builtin_amdgcn_mfma_f32_32x32x16_bf16(pa0,PK(0),o[d0],0,0,0);
    o[d0]=__builtin_amdgcn_mfma_f32_32x32x16_bf16(pa1,PK(1),o[d0],0,0,0);
    o[d0]=__builtin_amdgcn_mfma_f32_32x32x16_bf16(pa2,PK(2),o[d0],0,0,0);
    o[d0]=__builtin_amdgcn_mfma_f32_32x32x16_bf16(pa3,PK(3),o[d0],0,0,0);
    #undef PK
  }
}

#ifndef ATTN_STORE16
#define ATTN_STORE16(p,v) (*(u32x4*)(p)=(v))
#endif
template<int THRL,bool FIXEDM=false> __device__ __forceinline__ void attn_unit(const bf16*Qu,const bf16*__restrict__ Kh,const bf16*__restrict__ Vh,bf16*Ou,const int DM,const int OP,const int NT,char*shm,const float kmaxs=0.f){
  int tid=threadIdx.x; asm volatile("":"+v"(tid));
  const int lane=tid&63,r32=lane&31,hi=lane>>5; const int wid=__builtin_amdgcn_readfirstlane(tid>>6);
  const bf16*Qw=Qu+(long)(wid*QBLK)*DM;
  const unsigned lds0=(unsigned)(uintptr_t)shm;
  float*wsf=(float*)(shm+LDS_WS)+wid*64;
  const unsigned koff=(unsigned)(lane*DM+wid*8)*2u;
  const unsigned voff0=(unsigned)((16*((2*wid)&3)+(lane>>2))*DM+((2*wid)>>2)*32+(lane&3)*8)*2u;
  const unsigned voff1=(unsigned)((16*((2*wid+1)&3)+(lane>>2))*DM+((2*wid+1)>>2)*32+(lane&3)*8)*2u;
  const unsigned kdst=lds0+LDS_K+wid*1024, vdst=lds0+LDS_V+wid*2048;
  #define DMA_K(t,slot) glds16s(Kh+(long)(t)*KVBLK*DM,koff,(unsigned)__builtin_amdgcn_readfirstlane(kdst+(slot)))
  #define DMA_V(t,slot) do{ glds16s(Vh+(long)(t)*KVBLK*DM,voff0,(unsigned)__builtin_amdgcn_readfirstlane(vdst+2*(slot))); glds16s(Vh+(long)(t)*KVBLK*DM,voff1,(unsigned)__builtin_amdgcn_readfirstlane(vdst+1024+2*(slot))); }while(0)
  const char*Kbase=shm+LDS_K;
  #define KLD(ko,i) (*(const __attribute__((address_space(3))) bf16x8*)(kp0+(ko)+((i)>>1)*2048+((i)&1)*512))
  const lds_cptr shm3=(lds_cptr)shm; const lds_cptr kp0=shm3+LDS_K+hi*1024+r32*16; const lds_cptr vp0=shm3+LDS_V+((lane>>4)&1)*32+(lane&3)*8+(4*hi+((lane&15)>>2))*64;
  if(wid>=4)__builtin_amdgcn_s_setprio(1);
  DMA_K(0,0);DMA_V(0,0);DMA_K(1,SLOTB);
  bf16x8 qr[4];
  #pragma unroll
  for(int d0=0;d0<4;++d0)qr[d0]=*reinterpret_cast<const bf16x8*>(&Qw[(long)r32*DM+d0*16+hi*8]);
  float mb=0.f;
  if constexpr(FIXEDM){ float q2=0.f;
    _Pragma("unroll") for(int d0=0;d0<4;++d0){ const u32x4 w_=__builtin_bit_cast(u32x4,qr[d0]);
      _Pragma("unroll") for(int e=0;e<4;++e){ const float lo_=__uint_as_float(w_[e]<<16),hi_=__uint_as_float(w_[e]&0xffff0000u); q2+=lo_*lo_+hi_*hi_; } }
    { auto rr=__builtin_amdgcn_permlane32_swap(__float_as_uint(q2),__float_as_uint(q2),false,false); q2=__uint_as_float(rr[0])+__uint_as_float(rr[1]); }
    mb=__builtin_sqrtf(q2)*kmaxs; }
  const __attribute__((address_space(3))) bf16x8* qlp=(const __attribute__((address_space(3))) bf16x8*)(shm3+LDS_OST+wid*8192+lane*16);
  #pragma unroll
  for(int d0=0;d0<4;++d0)*(__attribute__((address_space(3))) bf16x8*)(shm3+LDS_OST+wid*8192+lane*16+d0*1024)=qr[d0];
  float mhat=0.f,l_reg=0.f;f32x16 o[4];o[0]=f32x16{};o[1]=f32x16{};o[2]=f32x16{};o[3]=f32x16{};f32x16 negm=f32x16{};asm volatile("":"+v"(negm));
  #define CMASK(P0,P1,t) do{}while(0)
  bool resc=false;
  #define START(P0,P1) do{ const float rm=FIXEDM?mb:rowmax(P0,P1); resc=false; \
    { const float dl=rm; mhat=fadd_s(mhat,dl); \
      _Pragma("unroll") for(int r=0;r<16;++r){P0[r]=fsub_s(P0[r],dl);P1[r]=fsub_s(P1[r],dl);} \
      _Pragma("unroll") for(int r=0;r<16;++r)negm[r]=-mhat; asm volatile("":"+v"(negm)); } \
    _Pragma("unroll") for(int r=0;r<16;++r)P0[r]=__builtin_amdgcn_exp2f(P0[r]); }while(0)
  #define RESC() do{ if(resc){ asm volatile("s_waitcnt lgkmcnt(0)":::"memory"); \
      _Pragma("unroll") for(int d_=0;d_<4;++d_) _Pragma("unroll") for(int r=0;r<16;++r)o[d_][r]*=wsf[crow(r,hi)]; } }while(0)
  f32x16 c0,c1;
  u32x4 pwA0,pwA1,pwA2,pwA3,pwB0,pwB1,pwB2,pwB3;
  int sl_prev=0,sl_cur=0,sl_next=SLOTB;
  int kc=0;
  #define KNEXT(n) ((kc+(n)*SLOTB)&(KSLOTS*SLOTB-1))
  #define ROT() do{sl_prev=sl_cur;sl_cur=sl_next;sl_next=(sl_next==(NSLOT-1)*SLOTB)?0:sl_next+SLOTB;kc=KNEXT(1);}while(0)
  #define PKW(P,B) cvtpk_s(P[B],P[B+1])
  DMA_K(2,2*SLOTB);
  WAIT_BAR(4);
  qkt(c0,c1,Kbase,qr,negm,r32,hi);asm volatile("s_nop 15\n\ts_nop 7":"+v"(c0),"+v"(c1));
  START(c0,c1);
  _Pragma("unroll") for(int r=0;r<16;++r)c1[r]=__builtin_amdgcn_exp2f(c1[r]);
  { float sacc=c0[0]+c0[1]; _Pragma("unroll") for(int r=2;r<16;++r)sacc+=c0[r]; _Pragma("unroll") for(int r=0;r<16;++r)sacc+=c1[r]; l_reg+=sacc;
    pwA0=(u32x4){PKW(c0,0),PKW(c0,2),PKW(c0,4),PKW(c0,6)};pwA1=(u32x4){PKW(c0,8),PKW(c0,10),PKW(c0,12),PKW(c0,14)};pwA2=(u32x4){PKW(c1,0),PKW(c1,2),PKW(c1,4),PKW(c1,6)};pwA3=(u32x4){PKW(c1,8),PKW(c1,10),PKW(c1,12),PKW(c1,14)}; }
  WAIT_BAR(0);
  DMA_K(3,3*SLOTB);DMA_V(1,SLOTB);
  ROT();
  bf16x8 ka0=KLD(kc,0),ka1=KLD(kc,1);
  WAIT_BAR(3);
  s16x4 vlo[4],vhi[4]; bf16x8 q0_=qr[0],q1_=qr[1];
  #define PAF(S,k) __builtin_bit_cast(bf16x8,pw##S##k)
  #define VFR(i) (bf16x8){vlo[i][0],vlo[i][1],vlo[i][2],vlo[i][3],vhi[i][0],vhi[i][1],vhi[i][2],vhi[i][3]}
  #define PIN(x) asm volatile("":"+v"(x))
  #define MX3(a,b,c) __builtin_fmaxf(__builtin_fmaxf((a),(b)),(c))
  #define EX(v) __builtin_amdgcn_exp2f(v)
  #define GAPA(MF) do{ MF; SBAR(); }while(0)
  #define GAPB(MF,X,B,PWV,WI,RL) do{ MF; X[B]=EX(X[B]); X[B+1]=EX(X[B+1]); sacc+=X[B]; sacc+=X[B+1]; PWV[WI]=PKW(X,B); PIN(PWV); PIN(sacc); RL; SBAR(); }while(0)
  #define VRD(s,d,ks) do{ vlo[s]=vtr(vp_+((d)*4096+(ks)*1024)); vhi[s]=vtr(vp_+((d)*4096+(ks)*1024+512)); }while(0)
  #define KRD(G,j) do{ if(G){ kload2(kf,kp0+sl_next,j); SBAR(); } }while(0)
  #define NOP_() do{}while(0)
  #define MF32(a,b,c) __builtin_amdgcn_mfma_f32_32x32x16_bf16(a,b,c,0,0,0)
  #define STEP(N,O,t,GK,GV,GL) do{ SBAR(); \
    const lds_cptr vp_=vp0+2*sl_prev; \
    const bf16x8 kb2=KLD(kc,2),kb3=KLD(kc,3); const bf16x8 q2_=qlp[128]; SBAR(); GAPA(c0=MF32(ka0,q0_,negm)); \
    const bf16x8 q3_=qlp[192]; SBAR(); GAPA(c1=MF32(ka1,q0_,negm)); \
    const bf16x8 kb4=KLD(kc,4),kb5=KLD(kc,5); SBAR(); GAPA(c0=MF32(kb2,q1_,c0)); \
    GAPA(c1=MF32(kb3,q1_,c1)); \
    const bf16x8 kb6=KLD(kc,6),kb7=KLD(kc,7); VRD(0,0,0); SBAR(); GAPA(c0=MF32(kb4,q2_,c0)); \
    VRD(1,1,0); SBAR(); GAPA(c1=MF32(kb5,q2_,c1)); \
    VRD(2,2,0); SBAR(); GAPA(c0=MF32(kb6,q3_,c0)); \
    VRD(3,3,0); SBAR(); GAPA(c1=MF32(kb7,q3_,c1)); \
    if(GK){DMA_K((t)+3,KNEXT(3));} if(GV){DMA_V((t)+1,sl_next);} \
    if constexpr(!FIXEDM){ float a=MX3(c0[0],c0[1],c1[0]),b=MX3(c0[2],c0[3],c1[1]); a=MX3(a,c1[2],c1[3]); \
      _Pragma("unroll") for(int r=4;r<16;r+=4){a=MX3(a,c0[r],c0[r+1]);b=MX3(b,c0[r+2],c0[r+3]);a=MX3(a,c1[r],c1[r+1]);b=MX3(b,c1[r+2],c1[r+3]);} \
      float rm=__builtin_fmaxf(a,b); { auto rr=__builtin_amdgcn_permlane32_swap(__float_as_uint(rm),__float_as_uint(rm),false,false); rm=__builtin_fmaxf(__uint_as_float(rr[0]),__uint_as_float(rr[1])); } \
      resc=false; \
      if(__builtin_expect(__any(rm>(float)THRL),0)){ const float dl=__builtin_fmaxf(rm,0.f); mhat+=dl; \
        _Pragma("unroll") for(int r=0;r<16;++r){c0[r]-=dl;c1[r]-=dl;} \
        _Pragma("unroll") for(int r=0;r<16;++r)negm[r]=-mhat; asm volatile("":"+v"(negm)); \
        const float f=__builtin_amdgcn_exp2f(-dl); l_reg*=f; if(hi==0)wsf[r32]=f; resc=true; } } \
    SBAR(); float sacc=0.f; \
    GAPB(o[0]=MF32(PAF(O,0),VFR(0),o[0]), c0,0,  pw##N##0,0, VRD(0,0,1)); \
    GAPB(o[1]=MF32(PAF(O,0),VFR(1),o[1]), c0,2,  pw##N##0,1, VRD(1,1,1)); \
    GAPB(o[2]=MF32(PAF(O,0),VFR(2),o[2]), c0,4,  pw##N##0,2, VRD(2,2,1)); \
    GAPB(o[3]=MF32(PAF(O,0),VFR(3),o[3]), c0,6,  pw##N##0,3, VRD(3,3,1)); \
    GAPB(o[0]=MF32(PAF(O,1),VFR(0),o[0]), c0,8,  pw##N##1,0, VRD(0,0,2)); \
    GAPB(o[1]=MF32(PAF(O,1),VFR(1),o[1]), c0,10, pw##N##1,1, VRD(1,1,2)); \
    GAPB(o[2]=MF32(PAF(O,1),VFR(2),o[2]), c0,12, pw##N##1,2, VRD(2,2,2)); \
    GAPB(o[3]=MF32(PAF(O,1),VFR(3),o[3]), c0,14, pw##N##1,3, VRD(3,3,2)); \
    GAPB(o[0]=MF32(PAF(O,2),VFR(0),o[0]), c1,0,  pw##N##2,0, VRD(0,0,3)); \
    GAPB(o[1]=MF32(PAF(O,2),VFR(1),o[1]), c1,2,  pw##N##2,1, VRD(1,1,3)); \
    GAPB(o[2]=MF32(PAF(O,2),VFR(2),o[2]), c1,4,  pw##N##2,2, VRD(2,2,3)); \
    GAPB(o[3]=MF32(PAF(O,2),VFR(3),o[3]), c1,6,  pw##N##2,3, VRD(3,3,3)); \
    GAPB(o[0]=MF32(PAF(O,3),VFR(0),o[0]), c1,8,  pw##N##3,0, ka0=KLD(KNEXT(1),0)); \
    GAPB(o[1]=MF32(PAF(O,3),VFR(1),o[1]), c1,10, pw##N##3,1, ka1=KLD(KNEXT(1),1)); \
    GAPB(o[2]=MF32(PAF(O,3),VFR(2),o[2]), c1,12, pw##N##3,2, q0_=qlp[0]); \
    GAPB(o[3]=MF32(PAF(O,3),VFR(3),o[3]), c1,14, pw##N##3,3, q1_=qlp[64]); \
    l_reg+=sacc; \
    }while(0)
  int t=1;
  for(;t+5<NT;t+=2){
    STEP(B,A,t,true,true,true);     WAIT_BAR(3); RESC(); ROT();
    STEP(A,B,t+1,true,true,true);   WAIT_BAR(3); RESC(); ROT();
  }
  #define ENDW(tt) do{ if((tt)+3<NT){WAIT_BAR(3);} else if((tt)+2<NT){WAIT_BAR(2);} else {WAIT_BAR(0);} }while(0)
  for(;t+1<NT;t+=2){
    STEP(B,A,t,(t+3<NT),(t+1<NT),(t+1<NT));       ENDW(t);   RESC(); ROT();
    STEP(A,B,t+1,(t+4<NT),(t+2<NT),(t+2<NT));     ENDW(t+1); RESC(); ROT();
  }
  STEP(B,A,NT-1,false,false,false); RESC();
  { SBAR(); const int vb0=(int)(lds0+LDS_V)+((lane>>4)&1)*32+(lane&3)*8+(4*hi+((lane&15)>>2))*64; pv(o,vb0+2*sl_cur,PAF(B,0),PAF(B,1),PAF(B,2),PAF(B,3)); }
  #undef PKW
  #undef PAF
  #undef VFR
  #undef PIN
  #undef MX3
  #undef GAPA
  #undef GAPB
  #undef EX
  #undef VRD
  #undef KRD
  #undef STEP
  #undef KLD
  #undef KNEXT
  #undef NOP_
  #undef MF32
  #undef ENDW
  {auto rr=__builtin_amdgcn_permlane32_swap(__float_as_uint(l_reg),__float_as_uint(l_reg),false,false);l_reg=__uint_as_float(rr[0])+__uint_as_float(rr[1]);}
  if(hi==0)wsf[32+r32]=l_reg;asm volatile("s_waitcnt lgkmcnt(0)":::"memory");
  float rli[16];
  #pragma unroll
  for(int r=0;r<16;++r)rli[r]=__builtin_amdgcn_rcpf(wsf[32+crow(r,hi)]);
  bf16*Ow=Ou+(long)(wid*QBLK)*OP;
  { bf16*stg=(bf16*)(shm+LDS_OST)+wid*4096;
    #pragma unroll
    for(int r=0;r<16;++r){const int orow=crow(r,hi);
      #pragma unroll
      for(int d0=0;d0<4;++d0)stg[orow*128+d0*32+r32]=__float2bfloat16(o[d0][r]*rli[r]);}
    asm volatile("s_waitcnt lgkmcnt(0)":::"memory");
    #pragma unroll
    for(int i=0;i<8;++i){const int row=i*4+(lane>>4),ch=lane&15; const u32x4 v=*(const u32x4*)(stg+row*128+ch*8); ATTN_STORE16(Ow+(long)row*OP+ch*8,v);} }
  asm volatile("s_waitcnt lgkmcnt(0)\n\ts_barrier":::"memory");
  if(wid>=4)__builtin_amdgcn_s_setprio(0);
  #undef DMA_K
  #undef DMA_V
  #undef CMASK
  #undef START
  #undef RESC
  #undef ROT
}
constexpr int ATTN_LDS_BYTES=LDS_BYTES;
}

namespace attn_msk {
using bf16=__hip_bfloat16;
using bf16x8=__attribute__((ext_vector_type(8)))short;
using s16x4=__attribute__((ext_vector_type(4)))short;
using f32x16=__attribute__((ext_vector_type(16)))float;
using u32x4=__attribute__((ext_vector_type(4)))unsigned;
constexpr int D=64;
constexpr int NW=8,QBLK=32,QB=QBLK*NW,KVBLK=64;
__device__ __forceinline__ int crow(int r,int hi){return (r&3)+8*(r>>2)+4*hi;}
#define SBAR() __builtin_amdgcn_sched_barrier(0)
constexpr int NSLOT=3, SLOTB=8192;
constexpr int KSLOTS=4, LDS_K=0, LDS_V=KSLOTS*SLOTB, LDS_WS=LDS_V+NSLOT*SLOTB, LDS_OST=LDS_WS+NW*64*4, LDS_BYTES=LDS_OST+NW*4096;
constexpr float C2=0.125f*1.4426950408889634f;
__device__ __forceinline__ void glds16(const void*gsrc,unsigned lds_dst){unsigned keep;
  asm volatile("s_mov_b32 %0, m0\n\ts_mov_b32 m0, %2\n\ts_nop 0\n\tglobal_load_lds_dwordx4 %1, off\n\ts_mov_b32 m0, %0":"=&s"(keep):"v"(gsrc),"s"(lds_dst):"memory");}
__device__ __forceinline__ void glds16s(const void*gbase,unsigned voff,unsigned lds_dst){unsigned keep;
  asm volatile("s_mov_b32 %0, m0\n\ts_mov_b32 m0, %3\n\ts_nop 0\n\tglobal_load_lds_dwordx4 %1, %2\n\ts_mov_b32 m0, %0":"=&s"(keep):"v"(voff),"s"(gbase),"s"(lds_dst):"memory");}
__device__ __forceinline__ float max3f(float a,float b,float c){float r;asm("v_max3_f32 %0, %1, %2, %3":"=v"(r):"v"(a),"v"(b),"v"(c));return r;}
__device__ __forceinline__ float max2f(float a,float b){float r;asm("v_max_f32_e32 %0, %1, %2":"=v"(r):"v"(a),"v"(b));return r;}
__device__ __forceinline__ float fadd_s(float a,float b){float r;asm("v_add_f32_e32 %0, %1, %2":"=v"(r):"v"(a),"v"(b));return r;}
__device__ __forceinline__ float fsub_s(float a,float b){float r;asm("v_sub_f32_e32 %0, %1, %2":"=v"(r):"v"(a),"v"(b));return r;}
typedef float f32x2_t __attribute__((ext_vector_type(2))); typedef __bf16 bf16x2_t __attribute__((ext_vector_type(2)));
__device__ __forceinline__ unsigned cvtpk_s(float lo,float hi){f32x2_t v={lo,hi};bf16x2_t b=__builtin_convertvector(v,bf16x2_t);return __builtin_bit_cast(unsigned,b);}
#define WAIT_BAR(N) asm volatile("s_waitcnt vmcnt(" #N ") lgkmcnt(0)\n\ts_barrier":::"memory")

__device__ __forceinline__ void qkt(f32x16&p0,f32x16&p1,const char*Kslot,const bf16x8*qr,const f32x16&negm,int r32,int hi){
  const char*kb=Kslot+hi*1024+r32*16;
  #pragma unroll
  for(int d0=0;d0<4;++d0){
    const bf16x8 b0=*reinterpret_cast<const bf16x8*>(kb+d0*2048);
    const bf16x8 b1=*reinterpret_cast<const bf16x8*>(kb+d0*2048+512);
    if(d0==0){p0=__builtin_amdgcn_mfma_f32_32x32x16_bf16(b0,qr[0],negm,0,0,0);p1=__builtin_amdgcn_mfma_f32_32x32x16_bf16(b1,qr[0],negm,0,0,0);}
    else{p0=__builtin_amdgcn_mfma_f32_32x32x16_bf16(b0,qr[d0],p0,0,0,0);p1=__builtin_amdgcn_mfma_f32_32x32x16_bf16(b1,qr[d0],p1,0,0,0);}}
}
typedef __attribute__((address_space(3))) const char* lds_cptr;
typedef short v4i16_t __attribute__((ext_vector_type(4)));
__device__ __forceinline__ void kload8(bf16x8*kf,lds_cptr kp){
  kf[0]=*(const __attribute__((address_space(3))) bf16x8*)(kp);      kf[1]=*(const __attribute__((address_space(3))) bf16x8*)(kp+512);
  kf[2]=*(const __attribute__((address_space(3))) bf16x8*)(kp+2048); kf[3]=*(const __attribute__((address_space(3))) bf16x8*)(kp+2560);
  kf[4]=*(const __attribute__((address_space(3))) bf16x8*)(kp+4096); kf[5]=*(const __attribute__((address_space(3))) bf16x8*)(kp+4608);
  kf[6]=*(const __attribute__((address_space(3))) bf16x8*)(kp+6144); kf[7]=*(const __attribute__((address_space(3))) bf16x8*)(kp+6656);
}
__device__ __forceinline__ void kload2(bf16x8*kf,lds_cptr kp,int j){ kf[2*j]=*(const __attribute__((address_space(3))) bf16x8*)(kp+j*2048); kf[2*j+1]=*(const __attribute__((address_space(3))) bf16x8*)(kp+j*2048+512); }
__device__ __forceinline__ s16x4 vtr(lds_cptr p){ return __builtin_bit_cast(s16x4,__builtin_amdgcn_ds_read_tr16_b64_v4i16((__attribute__((address_space(3))) v4i16_t*)p)); }
__device__ __forceinline__ float rowmax(const f32x16&p0,const f32x16&p1){
  float a=max3f(p0[0],p0[1],p1[0]),b=max3f(p0[2],p0[3],p1[1]);a=max3f(a,p1[2],p1[3]);
  #pragma unroll
  for(int r=4;r<16;r+=4){a=max3f(a,p0[r],p0[r+1]);b=max3f(b,p0[r+2],p0[r+3]);a=max3f(a,p1[r],p1[r+1]);b=max3f(b,p1[r+2],p1[r+3]);}
  const float m=max2f(a,b);
  auto rr=__builtin_amdgcn_permlane32_swap(__float_as_uint(m),__float_as_uint(m),false,false);
  return max2f(__uint_as_float(rr[0]),__uint_as_float(rr[1]));
}
__device__ __forceinline__ void pv(f32x16*o,int vb,bf16x8 pa0,bf16x8 pa1,bf16x8 pa2,bf16x8 pa3){
  #pragma unroll
  for(int d0=0;d0<2;++d0){s16x4 lo[4],hi[4];
    #pragma unroll
    for(int ks=0;ks<4;++ks){
      asm volatile("ds_read_b64_tr_b16 %0,%1 offset:%c2":"=&v"(lo[ks]):"v"(vb),"i"(d0*4096+ks*1024):"memory");
      asm volatile("ds_read_b64_tr_b16 %0,%1 offset:%c2":"=&v"(hi[ks]):"v"(vb),"i"(d0*4096+ks*1024+512):"memory");}
    asm volatile("s_waitcnt lgkmcnt(0)":::"memory");SBAR();
    #define PK(k) (bf16x8){lo[k][0],lo[k][1],lo[k][2],lo[k][3],hi[k][0],hi[k][1],hi[k][2],hi[k][3]}
    o[d0]=__builtin_amdgcn_mfma_f32_32x32x16_bf16(pa0,PK(0),o[d0],0,0,0);
    o[d0]=__builtin_amdgcn_mfma_f32_32x32x16_bf16(pa1,PK(1),o[d0],0,0,0);
    o[d0]=__builtin_amdgcn_mfma_f32_32x32x16_bf16(pa2,PK(2),o[d0],0,0,0);
    o[d0]=__builtin_amdgcn_mfma_f32_32x32x16_bf16(pa3,PK(3),o[d0],0,0,0);
    #undef PK
  }
}

#ifndef ATTN_STORE16
#define ATTN_STORE16(p,v) (*(u32x4*)(p)=(v))
#endif
template<int THRL,int MODE> __device__ __forceinline__ void attn_unit(const bf16*Qu,const bf16*__restrict__ Kh,const bf16*__restrict__ Vh,bf16*Ou,const int DM,const int OP,const int NT,char*shm,
                                                                     const int q0,const int base,const int nrows,const float sinkl2,const __attribute__((address_space(3))) float*rpb){
  const int tid=threadIdx.x,lane=tid&63,r32=lane&31,hi=lane>>5; const int wid=__builtin_amdgcn_readfirstlane(tid>>6);
  const bf16*Qw=Qu+(long)(wid*QBLK)*DM;
  const unsigned lds0=(unsigned)(uintptr_t)shm;
  float*wsf=(float*)(shm+LDS_WS)+wid*64;
  const unsigned koff=(unsigned)(lane*DM+wid*8)*2u;
  const unsigned voff0=(unsigned)((16*(wid&3)+(lane>>2))*DM+(wid>>2)*32+(lane&3)*8)*2u;
  const unsigned kdst=lds0+LDS_K+wid*1024, vdst=lds0+LDS_V+wid*1024;
  #define ROWOFF(t) ((t)<4?8192+64*(t):(MODE==2&&(t)-4>=nrows?base:base+64*((t)-4)))
  #define DMA_K(t,slot) glds16s(Kh+(long)ROWOFF(t)*DM,koff,(unsigned)__builtin_amdgcn_readfirstlane(kdst+(slot)))
  #define DMA_V(t,slot) glds16s(Vh+(long)ROWOFF(t)*DM,voff0,(unsigned)__builtin_amdgcn_readfirstlane(vdst+(slot)))
  const char*Kbase=shm+LDS_K;
  #define KLD(ko,i) (*(const __attribute__((address_space(3))) bf16x8*)(kp0+(ko)+((i)>>1)*2048+((i)&1)*512))
  const lds_cptr shm3=(lds_cptr)shm; const lds_cptr kp0=shm3+LDS_K+hi*1024+r32*16; const lds_cptr vp0=shm3+LDS_V+((lane>>4)&1)*32+(lane&3)*8+(4*hi+((lane&15)>>2))*64;
  if(wid>=4)__builtin_amdgcn_s_setprio(1);
  DMA_K(0,0);DMA_V(0,0);DMA_K(1,SLOTB);
  bf16x8 qr[4];
  #pragma unroll
  for(int d0=0;d0<4;++d0)qr[d0]=*reinterpret_cast<const bf16x8*>(&Qw[(long)r32*DM+d0*16+hi*8]);
  const __attribute__((address_space(3))) bf16x8* qlp=(const __attribute__((address_space(3))) bf16x8*)(shm3+LDS_OST+wid*4096+lane*16);
  #pragma unroll
  for(int d0=0;d0<4;++d0)*(__attribute__((address_space(3))) bf16x8*)(shm3+LDS_OST+wid*4096+lane*16+d0*1024)=qr[d0];
  float mhat=0.f,l_reg=0.f;f32x16 o[2];o[0]=f32x16{};o[1]=f32x16{};f32x16 negm=f32x16{};asm volatile("":"+v"(negm));
  const int qpos=q0+wid*QBLK+r32;
  const int rq=(q0+wid*QBLK)>>6,cq=qpos&63;
  const int r0q=rq-4<0?0:(rq-4>120?120:rq-4), csq=cq-8<0?0:(cq-8>48?48:cq-8);
  #define CMASK(P0,P1,t) do{ if((t)>=4){ \
      if(MODE==1){ const int d_=qpos-(base+64*((t)-4)+4*hi); \
        _Pragma("unroll") for(int r=0;r<16;++r){ const int dd=d_-((r&3)+8*(r>>2)); if(dd>128||dd<-128)P0[r]=-INFINITY; if(dd-32>128||dd-32<-128)P1[r]=-INFINITY; } } \
      else { const int kr_=(base>>6)+(t)-4; const bool rok_=((t)-4<nrows)&&kr_>=r0q&&kr_<r0q+8; \
        const __attribute__((address_space(3))) float*bp_=rpb+((rok_?kr_-rq+7:7)*31+15-cq); \
        _Pragma("unroll") for(int r=0;r<16;++r){ const int k0_=(r&3)+8*(r>>2)+4*hi,k1_=k0_+32; \
          if(rok_&&k0_>=csq&&k0_<csq+16)P0[r]+=bp_[k0_]; else P0[r]=-INFINITY; \
          if(rok_&&k1_>=csq&&k1_<csq+16)P1[r]+=bp_[k1_]; else P1[r]=-INFINITY; } } } }while(0)
  bool resc=false;
  #define START(P0,P1) do{ const float rm=rowmax(P0,P1); resc=false; \
    { const float dl=rm; mhat=fadd_s(mhat,dl); \
      _Pragma("unroll") for(int r=0;r<16;++r){P0[r]=fsub_s(P0[r],dl);P1[r]=fsub_s(P1[r],dl);} \
      _Pragma("unroll") for(int r=0;r<16;++r)negm[r]=-mhat; asm volatile("":"+v"(negm)); } \
    _Pragma("unroll") for(int r=0;r<16;++r)P0[r]=__builtin_amdgcn_exp2f(P0[r]); }while(0)
  #define RESC() do{ if(resc){ asm volatile("s_waitcnt lgkmcnt(0)":::"memory"); \
      _Pragma("unroll") for(int d_=0;d_<2;++d_) _Pragma("unroll") for(int r=0;r<16;++r)o[d_][r]*=wsf[crow(r,hi)]; } }while(0)
  f32x16 c0,c1;
  u32x4 pwA0,pwA1,pwA2,pwA3,pwB0,pwB1,pwB2,pwB3;
  int sl_prev=0,sl_cur=0,sl_next=SLOTB;
  int kc=0;
  #define KNEXT(n) ((kc+(n)*SLOTB)&(KSLOTS*SLOTB-1))
  #define ROT() do{sl_prev=sl_cur;sl_cur=sl_next;sl_next=(sl_next==(NSLOT-1)*SLOTB)?0:sl_next+SLOTB;kc=KNEXT(1);}while(0)
  #define PKW(P,B) cvtpk_s(P[B],P[B+1])
  DMA_K(2,2*SLOTB);
  WAIT_BAR(3);
  qkt(c0,c1,Kbase,qr,negm,r32,hi);asm volatile("s_nop 15\n\ts_nop 7":"+v"(c0),"+v"(c1));CMASK(c0,c1,0);
  START(c0,c1);
  _Pragma("unroll") for(int r=0;r<16;++r)c1[r]=__builtin_amdgcn_exp2f(c1[r]);
  { float sacc=c0[0]+c0[1]; _Pragma("unroll") for(int r=2;r<16;++r)sacc+=c0[r]; _Pragma("unroll") for(int r=0;r<16;++r)sacc+=c1[r]; l_reg+=sacc;
    pwA0=(u32x4){PKW(c0,0),PKW(c0,2),PKW(c0,4),PKW(c0,6)};pwA1=(u32x4){PKW(c0,8),PKW(c0,10),PKW(c0,12),PKW(c0,14)};pwA2=(u32x4){PKW(c1,0),PKW(c1,2),PKW(c1,4),PKW(c1,6)};pwA3=(u32x4){PKW(c1,8),PKW(c1,10),PKW(c1,12),PKW(c1,14)}; }
  WAIT_BAR(0);
  DMA_K(3,3*SLOTB);DMA_V(1,SLOTB);
  ROT();
  bf16x8 ka0=KLD(kc,0),ka1=KLD(kc,1);
  WAIT_BAR(2);
  s16x4 vlo[4],vhi[4]; bf16x8 q0_=qr[0],q1_=qr[1];
  #define PAF(S,k) __builtin_bit_cast(bf16x8,pw##S##k)
  #define VFR(i) (bf16x8){vlo[i][0],vlo[i][1],vlo[i][2],vlo[i][3],vhi[i][0],vhi[i][1],vhi[i][2],vhi[i][3]}
  #define PIN(x) asm volatile("":"+v"(x))
  #define MX3(a,b,c) __builtin_fmaxf(__builtin_fmaxf((a),(b)),(c))
  #define EX(v) __builtin_amdgcn_exp2f(v)
  #define GAPA(MF) do{ MF; SBAR(); }while(0)
  #define GAPB(MF,X,B,PWV,WI,RL) do{ MF; X[B]=EX(X[B]); X[B+1]=EX(X[B+1]); X[B+2]=EX(X[B+2]); X[B+3]=EX(X[B+3]); sacc+=X[B]; sacc+=X[B+1]; sacc+=X[B+2]; sacc+=X[B+3]; PWV[WI]=PKW(X,B); PWV[WI+1]=PKW(X,B+2); PIN(PWV); PIN(sacc); RL; SBAR(); }while(0)
  #define VRD(s,d,ks) do{ vlo[s]=vtr(vp_+((d)*4096+(ks)*1024)); vhi[s]=vtr(vp_+((d)*4096+(ks)*1024+512)); }while(0)
  #define KRD(G,j) do{ if(G){ kload2(kf,kp0+sl_next,j); SBAR(); } }while(0)
  #define NOP_() do{}while(0)
  #define MF32(a,b,c) __builtin_amdgcn_mfma_f32_32x32x16_bf16(a,b,c,0,0,0)
  #define STEP(N,O,t,GK,GV,GL) do{ SBAR(); \
    const lds_cptr vp_=vp0+sl_prev; \
    const bf16x8 kb2=KLD(kc,2),kb3=KLD(kc,3); const bf16x8 q2_=qlp[128]; SBAR(); GAPA(c0=MF32(ka0,q0_,negm)); \
    const bf16x8 q3_=qlp[192]; SBAR(); GAPA(c1=MF32(ka1,q0_,negm)); \
    const bf16x8 kb4=KLD(kc,4),kb5=KLD(kc,5); SBAR(); GAPA(c0=MF32(kb2,q1_,c0)); \
    GAPA(c1=MF32(kb3,q1_,c1)); \
    const bf16x8 kb6=KLD(kc,6),kb7=KLD(kc,7); VRD(0,0,0); SBAR(); GAPA(c0=MF32(kb4,q2_,c0)); \
    VRD(1,1,0); SBAR(); GAPA(c1=MF32(kb5,q2_,c1)); \
    VRD(2,0,1); SBAR(); GAPA(c0=MF32(kb6,q3_,c0)); \
    VRD(3,1,1); SBAR(); GAPA(c1=MF32(kb7,q3_,c1)); \
    if(GK){DMA_K((t)+3,KNEXT(3));} if(GV){DMA_V((t)+1,sl_next);} \
    CMASK(c0,c1,t); \
    { float a=MX3(c0[0],c0[1],c1[0]),b=MX3(c0[2],c0[3],c1[1]); a=MX3(a,c1[2],c1[3]); \
      _Pragma("unroll") for(int r=4;r<16;r+=4){a=MX3(a,c0[r],c0[r+1]);b=MX3(b,c0[r+2],c0[r+3]);a=MX3(a,c1[r],c1[r+1]);b=MX3(b,c1[r+2],c1[r+3]);} \
      float rm=__builtin_fmaxf(a,b); { auto rr=__builtin_amdgcn_permlane32_swap(__float_as_uint(rm),__float_as_uint(rm),false,false); rm=__builtin_fmaxf(__uint_as_float(rr[0]),__uint_as_float(rr[1])); } \
      resc=false; \
      if(__builtin_expect(__any(rm>(float)THRL),0)){ const float dl=__builtin_fmaxf(rm,0.f); mhat+=dl; \
        _Pragma("unroll") for(int r=0;r<16;++r){c0[r]-=dl;c1[r]-=dl;} \
        _Pragma("unroll") for(int r=0;r<16;++r)negm[r]=-mhat; asm volatile("":"+v"(negm)); \
        const float f=__builtin_amdgcn_exp2f(-dl); l_reg*=f; if(hi==0)wsf[r32]=f; resc=true; } } \
    SBAR(); float sacc=0.f; \
    GAPB(o[0]=MF32(PAF(O,0),VFR(0),o[0]), c0,0,  pw##N##0,0, VRD(0,0,2)); \
    GAPB(o[1]=MF32(PAF(O,0),VFR(1),o[1]), c0,4,  pw##N##0,2, VRD(1,1,2)); \
    GAPB(o[0]=MF32(PAF(O,1),VFR(2),o[0]), c0,8,  pw##N##1,0, VRD(2,0,3)); \
    GAPB(o[1]=MF32(PAF(O,1),VFR(3),o[1]), c0,12, pw##N##1,2, VRD(3,1,3)); \
    GAPB(o[0]=MF32(PAF(O,2),VFR(0),o[0]), c1,0,  pw##N##2,0, ka0=KLD(KNEXT(1),0)); \
    GAPB(o[1]=MF32(PAF(O,2),VFR(1),o[1]), c1,4,  pw##N##2,2, ka1=KLD(KNEXT(1),1)); \
    GAPB(o[0]=MF32(PAF(O,3),VFR(2),o[0]), c1,8,  pw##N##3,0, q0_=qlp[0]); \
    GAPB(o[1]=MF32(PAF(O,3),VFR(3),o[1]), c1,12, pw##N##3,2, q1_=qlp[64]); \
    l_reg+=sacc; \
    }while(0)
  int t=1;
  for(;t+5<NT;t+=2){
    STEP(B,A,t,true,true,true);     WAIT_BAR(2); RESC(); ROT();
    STEP(A,B,t+1,true,true,true);   WAIT_BAR(2); RESC(); ROT();
  }
  #define ENDW(tt) do{ if((tt)+3<NT){WAIT_BAR(2);} else if((tt)+2<NT){WAIT_BAR(1);} else {WAIT_BAR(0);} }while(0)
  for(;t+1<NT;t+=2){
    STEP(B,A,t,(t+3<NT),(t+1<NT),(t+1<NT));       ENDW(t);   RESC(); ROT();
    STEP(A,B,t+1,(t+4<NT),(t+2<NT),(t+2<NT));     ENDW(t+1); RESC(); ROT();
  }
  STEP(B,A,NT-1,false,false,false); RESC();
  { SBAR(); const int vb0=(int)(lds0+LDS_V)+((lane>>4)&1)*32+(lane&3)*8+(4*hi+((lane&15)>>2))*64; pv(o,vb0+sl_cur,PAF(B,0),PAF(B,1),PAF(B,2),PAF(B,3)); }
  #undef PKW
  #undef PAF
  #undef VFR
  #undef PIN
  #undef MX3
  #undef GAPA
  #undef GAPB
  #undef EX
  #undef VRD
  #undef KRD
  #undef STEP
  #undef KLD
  #undef KNEXT
  #undef NOP_
  #undef MF32
  #undef ENDW
  {auto rr=__builtin_amdgcn_permlane32_swap(__float_as_uint(l_reg),__float_as_uint(l_reg),false,false);l_reg=__uint_as_float(rr[0])+__uint_as_float(rr[1]);}
  if(MODE==1)l_reg+=__builtin_amdgcn_exp2f(sinkl2-mhat);
  if(hi==0)wsf[32+r32]=l_reg;asm volatile("s_waitcnt lgkmcnt(0)":::"memory");
  float rli[16];
  #pragma unroll
  for(int r=0;r<16;++r)rli[r]=__builtin_amdgcn_rcpf(wsf[32+crow(r,hi)]);
  bf16*Ow=Ou+(long)(wid*QBLK)*OP;
  { bf16*stg=(bf16*)(shm+LDS_OST)+wid*2048;
    #pragma unroll
    for(int r=0;r<16;++r){const int orow=crow(r,hi);
      #pragma unroll
      for(int d0=0;d0<2;++d0)stg[orow*64+d0*32+r32]=__float2bfloat16(o[d0][r]*rli[r]);}
    asm volatile("s_waitcnt lgkmcnt(0)":::"memory");
    #pragma unroll
    for(int i=0;i<4;++i){const int row=i*8+(lane>>3),ch=lane&7; const u32x4 v=*(const u32x4*)(stg+row*64+ch*8); ATTN_STORE16(Ow+(long)row*OP+ch*8,v);} }
  asm volatile("s_waitcnt lgkmcnt(0)\n\ts_barrier":::"memory");
  if(wid>=4)__builtin_amdgcn_s_setprio(0);
  #undef DMA_K
  #undef ROWOFF
  #undef DMA_V
  #undef CMASK
  #undef START
  #undef RESC
  #undef ROT
}
constexpr int ATTN_LDS_BYTES=LDS_BYTES;
}

struct Args { const float* in[24]; float* out; unsigned char* ws; int ph_lo, ph_hi; };
struct Ctx {
    char* lds; int tid, lane, wid, bid, nblk, vcu;
    const float* const* in; float* out; unsigned char* ws;
};
#define WSP(T, off) ((T*)(C.ws + (off)))

__device__ __forceinline__ const float* hin_row(const Ctx& C, int row) {
    const int b = row / SP, t = row - b * SP;
    return t < SEQ ? C.in[0] + ((size_t)b * SEQ + t) * D : C.in[2] + ((size_t)b * NCTX + (t - SEQ)) * D;
}
__device__ __forceinline__ int row_set(int row) { const int b = row / SP, t = row - b * SP; return t < SEQ ? b : 2; }

struct ConvTile { const float* src; bf16_t* dst; int K, N; };
__device__ __forceinline__ ConvTile conv_decode(const Ctx& C, int tile) {
    constexpr int T_WIN = 144, T_WOUT = 64, T_EXP = 2048;
    ConvTile t; int m, ti;
    if (tile < 2 * T_WIN) { m = tile / T_WIN; ti = tile % T_WIN; t.src = C.in[m ? 13 : 8]; t.dst = WSP(bf16_t, WS_WIN) + (size_t)m * NQKV * D; t.K = D; t.N = NQKV; }
    else if ((tile -= 2 * T_WIN) < 2 * T_WOUT) { m = tile / T_WOUT; ti = tile % T_WOUT; t.src = C.in[m ? 14 : 9]; t.dst = WSP(bf16_t, WS_WOUT) + (size_t)m * D * D; t.K = D; t.N = D; }
    else if ((tile -= 2 * T_WOUT) < T_EXP) { m = tile >> 5; ti = tile & 31; t.src = C.in[21] + (size_t)m * 524288; t.dst = WSP(bf16_t, WS_W1) + (size_t)m * 524288; t.K = 1024; t.N = 512; }
    else if ((tile -= T_EXP) < T_EXP) { m = tile >> 5; ti = tile & 31; t.src = C.in[22] + (size_t)m * 524288; t.dst = WSP(bf16_t, WS_W3) + (size_t)m * 524288; t.K = 1024; t.N = 512; }
    else { tile -= T_EXP; m = tile >> 5; ti = tile & 31; t.src = C.in[23] + (size_t)m * 524288; t.dst = WSP(bf16_t, WS_W2) + (size_t)m * 524288; t.K = 512; t.N = 1024; }
    const int nn = t.N >> 8; const int kt = ti / nn, nt = ti % nn;
    t.src += (size_t)(kt * 64) * t.N + nt * 256; t.dst += (size_t)(nt * 256) * t.K + kt * 64;
    return t;
}
constexpr int CONV_EARLY = 2 * 144 + 2 * 64, CONV_TILES = CONV_EARLY + 3 * 2048;
constexpr int NORM_LDS = 153600;
constexpr int CW_NORM = 20480;
__device__ __forceinline__ ConvTile conv_decode_exp(const Ctx& C, int tile) {
    tile -= CONV_EARLY;
    const int cls = tile >> 11, m = (tile >> 5) & 63, ti = tile & 31;
    const int lg = cls < 2 ? 1 : 2;
    const int kt = ti >> lg, nt = ti & ((1 << lg) - 1);
    ConvTile t; t.N = 256 << lg; t.K = 2048 >> lg;
    const size_t wsoff = cls == 0 ? WS_W1 : (cls == 1 ? WS_W3 : WS_W2);
    t.src = C.in[21 + cls] + (size_t)m * 524288 + (size_t)(kt * 64) * t.N + nt * 256;
    t.dst = (bf16_t*)(C.ws + wsoff) + (size_t)m * 524288 + (size_t)(nt * 256) * t.K + kt * 64;
    return t;
}
template <bool EXP, int NT>
__device__ __forceinline__ void conv_tiles(const Ctx& C, int first, int step, int end) {
    int tid = C.tid; asm volatile("" : "+v"(tid));
    const int lane = tid & 63, wid = __builtin_amdgcn_readfirstlane(tid >> 6), kg = lane & 7, nq = lane >> 3;
    const int ncol = wid * 32 + nq * 4;
    f32x4 v[4][8];
#define CONV_LD(i_, tile_) do { const ConvTile t_ = EXP ? conv_decode_exp(C, (tile_)) : conv_decode(C, (tile_)); _Pragma("unroll") for (int r_ = 0; r_ < 8; ++r_) \
        v[i_][r_] = __builtin_nontemporal_load((const f32x4*)(t_.src + (size_t)(kg * 8 + r_) * t_.N + ncol)); __builtin_amdgcn_sched_barrier(0); } while (0)
#define CONV_ST(i_, tile_) do { const ConvTile t_ = EXP ? conv_decode_exp(C, (tile_)) : conv_decode(C, (tile_)); _Pragma("unroll") for (int j_ = 0; j_ < 4; ++j_) { u32x4 o_; \
        o_.x = cvtpk(v[i_][0][j_], v[i_][1][j_]); o_.y = cvtpk(v[i_][2][j_], v[i_][3][j_]); o_.z = cvtpk(v[i_][4][j_], v[i_][5][j_]); o_.w = cvtpk(v[i_][6][j_], v[i_][7][j_]); \
        __builtin_nontemporal_store(o_, (u32x4*)(t_.dst + (size_t)(ncol + j_) * t_.K + kg * 8)); } __builtin_amdgcn_sched_barrier(0); } while (0)
    if constexpr (NT > 0) {
#pragma unroll
        for (int j = 0; j < 4 && j < NT; ++j) CONV_LD(j, first + j * step);
#pragma unroll
        for (int j = 0; j < NT; ++j) { CONV_ST(j % 4, first + j * step); if (j + 4 < NT) CONV_LD(j % 4, first + (j + 4) * step); }
    } else {
        int tile = first;
#pragma unroll
        for (int i = 0; i < 4; ++i) if (tile + i * step < end) CONV_LD(i, tile + i * step);
        while (tile < end) {
#pragma unroll
            for (int i = 0; i < 4; ++i) {
                const int cur = tile + i * step, nxt = cur + 4 * step;
                if (cur < end) { CONV_ST(i, cur); if (nxt < end) CONV_LD(i, nxt); }
            }
            tile += 4 * step;
        }
    }
#undef CONV_LD
#undef CONV_ST
}
__device__ __forceinline__ void phase_prologue(const Ctx& C) {
    const int tid = C.tid;
    {
        float* sv = (float*)C.lds;
        float* red = (float*)(C.lds + 12288);
        for (int i = tid; i < 3072; i += NTHR) { const int set = i >> 10, k = i & 1023; const float v = set < 2 ? C.in[1][set * D + k] : C.in[3][k]; sv[i] = silu_f(v); }
        __syncthreads();
        float* mods = WSP(float, WS_MODS);
        for (int item = C.bid; item < 256; item += C.nblk) {
            const int layer = item >> 7, col0 = (item & 127) * 48;
            if (tid < 384) {
                const int cg = tid % 12, ks = tid / 12;
                f32x4 a0 = {0, 0, 0, 0}, a1 = a0, a2 = a0;
                const float* W = C.in[4] + (size_t)layer * D * 6144 + col0 + cg * 4;
                for (int kk = 0; kk < 32; ++kk) {
                    const int k = ks * 32 + kk;
                    const f32x4 w = *(const f32x4*)(W + (size_t)k * 6144);
                    a0 += sv[k] * w; a1 += sv[1024 + k] * w; a2 += sv[2048 + k] * w;
                }
                float* rp = red + (ks * 12 + cg) * 12;
                *(f32x4*)(rp) = a0; *(f32x4*)(rp + 4) = a1; *(f32x4*)(rp + 8) = a2;
            }
            __syncthreads();
            if (tid < 144) {
                const int cg = tid / 12, v = tid % 12;
                float s = 0.f;
                for (int ks = 0; ks < 32; ++ks) s += red[(ks * 12 + cg) * 12 + v];
                const int set = v >> 2, col = col0 + cg * 4 + (v & 3);
                mods[(layer * 3 + set) * 6144 + col] = s + C.in[5][layer * 6144 + col];
            }
            __syncthreads();
        }
    }
    {
        float* cs = WSP(float, WS_ROPE); float* sn = cs + SEQ * 32;
        for (int idx = C.bid * NTHR + tid; idx < SEQ * 32; idx += C.nblk * NTHR) {
            const int t = idx >> 5, j = idx & 31;
            const float pos = (float)(j < 16 ? (t >> 6) : (t & 63));
            const float inv = powf(10000.f, -(float)(j & 15) / 16.f);
            const float ang = pos * inv;
            float s, c; sincosf(ang, &s, &c);
            cs[idx] = c; sn[idx] = s;
        }
    }
    __syncthreads();
    conv_tiles<false, 0>(C, C.bid, C.nblk, CONV_EARLY);
}

__device__ __forceinline__ void store_row_bf16(bf16_t* rowp, int lane, const u32x2 (&o)[4]) {
    const bool odd = (lane & 1) != 0;
#pragma unroll
    for (int gp = 0; gp < 2; ++gp) {
        const u32x2 send = odd ? o[2 * gp] : o[2 * gp + 1];
        u32x2 recv; recv.x = (unsigned)__shfl_xor((int)send.x, 1); recv.y = (unsigned)__shfl_xor((int)send.y, 1);
        u32x4 v;
        if (!odd) { v.x = o[2 * gp].x; v.y = o[2 * gp].y; v.z = recv.x; v.w = recv.y; }
        else { v.x = recv.x; v.y = recv.y; v.z = o[2 * gp + 1].x; v.w = o[2 * gp + 1].y; }
        st16_wt(rowp + 256 * (2 * gp + (odd ? 1 : 0)) + 8 * (lane >> 1), v);
    }
}
__device__ __forceinline__ void phase_mod0(const Ctx& C) {
    const float* mods = WSP(float, WS_MODS);
    bf16_t* act = WSP(bf16_t, WS_ACT);
    for (int row = C.bid * 8 + C.wid; row < R; row += C.nblk * 8) {
        const float* src = hin_row(C, row); const float* m = mods + row_set(row) * 6144;
        u32x2 ob[4];
#pragma unroll
        for (int i = 0; i < 4; ++i) {
            const int col = C.lane * 4 + 256 * i;
            const f32x4 v = *(const f32x4*)(src + col), sh = *(const f32x4*)(m + col), sc = *(const f32x4*)(m + 1024 + col);
            const f32x4 a = v * (1.f + sc) + sh;
            ob[i].x = cvtpk(a[0], a[1]); ob[i].y = cvtpk(a[2], a[3]);
        }
        store_row_bf16(act + (size_t)row * D, C.lane, ob);
    }
    {
        const bf16_t* wo = WSP(bf16_t, WS_WOUT); bf16_t* wg = WSP(bf16_t, WS_WG);
        for (int row = C.bid * 8 + C.wid; row < 6 * D; row += C.nblk * 8) {
            const int ls = row >> 10, n = row & 1023, l = ls / 3;
            const float g = mods[(size_t)ls * 6144 + 2 * 1024 + n] * (1.f / ALPHA);
#pragma unroll
            for (int hf = 0; hf < 2; ++hf) {
                const u32x4 w = *(const u32x4*)(wo + ((size_t)l * D + n) * D + hf * 512 + C.lane * 8);
                u32x4 o;
                o.x = cvtpk(bf2f((unsigned short)(w.x & 0xffff)) * g, bf2f((unsigned short)(w.x >> 16)) * g); o.y = cvtpk(bf2f((unsigned short)(w.y & 0xffff)) * g, bf2f((unsigned short)(w.y >> 16)) * g);
                o.z = cvtpk(bf2f((unsigned short)(w.z & 0xffff)) * g, bf2f((unsigned short)(w.z >> 16)) * g); o.w = cvtpk(bf2f((unsigned short)(w.w & 0xffff)) * g, bf2f((unsigned short)(w.w >> 16)) * g);
                *(u32x4*)(wg + (size_t)row * D + hf * 512 + C.lane * 8) = o;
            }
        }
    }
}

__device__ __forceinline__ int xcd_item(const Ctx& C, int it) { return it * C.nblk + C.vcu; }
#define GEMM_SRC_CHUNK(tid) ((((tid) & 7) ^ ((((tid) >> 3) >> 1) & 7)))
constexpr int GEMM_LDS = 147456;
template <int KT, int NMI, bool PART = false, bool INIT = false>
__device__ __forceinline__ void gemm_core(char* lds, const bf16_t* const (&rp)[NMI + 4], f32x16 (&acc)[NMI][2], int tid, int nvalid = 256) {
    constexpr int AR = NMI * 64, NP = NMI + 4, STAGE = (AR + 256) * 128, SLOTS = NMI == 2 ? 3 : 2, PF = SLOTS - 1;
    static_assert(SLOTS * STAGE <= GEMM_LDS, "gemm ring");
    const int lane = tid & 63, wid = __builtin_amdgcn_readfirstlane(tid >> 6), r32 = lane & 31, hi = lane >> 5;
    const int wn = wid >> 2, wt = wid & 3;
    const int sw = (r32 >> 1) & 7;
    const int arow = (wn * (NMI * 32) + r32) * 128, brow = (AR + wt * 64 + r32) * 128;
    if constexpr (!INIT) {
#pragma unroll
        for (int mi = 0; mi < NMI; ++mi)
#pragma unroll
            for (int ti = 0; ti < 2; ++ti)
#pragma unroll
                for (int r = 0; r < 16; ++r) acc[mi][ti][r] = 0.f;
    }
    LAS char* l3 = (LAS char*)lds;
    const bool act0 = !PART || nvalid > wt * 64, act1 = !PART || nvalid > wt * 64 + 32;
#define GEMM_PIECE_ON(i_) (!PART || (i_) < NMI || 8 * (wid + 8 * (i_)) - AR < nvalid)
#define GEMM_DMA(kt_, slot_) do { _Pragma("unroll") for (int i_ = 0; i_ < NP; ++i_) if (GEMM_PIECE_ON(i_)) \
        __builtin_amdgcn_global_load_lds((const unsigned*)(rp[i_] + (kt_) * 64), (LAS unsigned*)(l3 + (slot_) * STAGE + (wid + 8 * i_) * 1024), 16, 0, 0); } while (0)
#define GEMM_WAIT(ntiles_) do { if (PART || (ntiles_) <= 0) asm volatile("s_waitcnt vmcnt(0)" ::: "memory"); else if (NP == 6) asm volatile("s_waitcnt vmcnt(6)" ::: "memory"); else asm volatile("s_waitcnt vmcnt(8)" ::: "memory"); } while (0)
    GEMM_DMA(0, 0);
    if (PF > 1 && KT > 1) { GEMM_DMA(1, 1); GEMM_WAIT(1); } else { GEMM_WAIT(0); }
    __builtin_amdgcn_s_barrier();
#pragma unroll
    for (int kt = 0; kt < KT; ++kt) {
        const char* cur = lds + (kt % SLOTS) * STAGE;
        __builtin_amdgcn_sched_barrier(0);
#pragma unroll
        for (int ks = 0; ks < 4; ++ks) {
            const int co = ((2 * ks + hi) ^ sw) << 4;
            bf16x8 a[NMI];
#pragma unroll
            for (int mi = 0; mi < NMI; ++mi) a[mi] = *(const bf16x8*)(cur + arow + mi * 32 * 128 + co);
            bf16x8 b0 = {}, b1 = {};
            if (act0) b0 = *(const bf16x8*)(cur + brow + co);
            if (act1) b1 = *(const bf16x8*)(cur + brow + 32 * 128 + co);
            if (kt + PF < KT) {
#pragma unroll
                for (int i_ = ks * NP / 4; i_ < (ks + 1) * NP / 4; ++i_) if (GEMM_PIECE_ON(i_))
                    __builtin_amdgcn_global_load_lds((const unsigned*)(rp[i_] + (kt + PF) * 64), (LAS unsigned*)(l3 + ((kt + PF) % SLOTS) * STAGE + (wid + 8 * i_) * 1024), 16, 0, 0);
            }
            __builtin_amdgcn_s_setprio(1);
            if (act0) {
#pragma unroll
                for (int mi = 0; mi < NMI; ++mi) acc[mi][0] = mfma32(a[mi], b0, acc[mi][0]);
            }
            if (act1) {
#pragma unroll
                for (int mi = 0; mi < NMI; ++mi) acc[mi][1] = mfma32(a[mi], b1, acc[mi][1]);
            }
            __builtin_amdgcn_s_setprio(0);
            __builtin_amdgcn_sched_barrier(0);
        }
        if (kt + 1 < KT) { GEMM_WAIT((kt + PF < KT ? kt + PF : KT - 1) - (kt + 1)); }
        __builtin_amdgcn_s_barrier();
    }
#undef GEMM_DMA
#undef GEMM_WAIT
#undef GEMM_PIECE_ON
}

template <int NCOL> struct WStage { static constexpr int P = NCOL * 2 + 16, BYTES = 64 * P, CH = NCOL / 8; };
template <int NCOL>
__device__ __forceinline__ void stage_put(char* wbuf, int row, int col, u32x2 v) { *(u32x2*)(wbuf + row * WStage<NCOL>::P + col * 2) = v; }
template <int NCOL>
__device__ __forceinline__ void stage_flush(const char* wbuf, int lane, bf16_t* base, size_t pitch, int nvalid) {
    constexpr int CH = WStage<NCOL>::CH;
    __builtin_amdgcn_sched_barrier(0);
#pragma unroll 4
    for (int i = 0; i < CH; ++i) {
        const int idx = i * 64 + lane, row = idx / CH, ch = idx % CH;
        const u32x4 v = *(const u32x4*)(wbuf + row * WStage<NCOL>::P + ch * 16);
        if (row < nvalid) st16_wt(base + (size_t)row * pitch + ch * 8, v);
    }
}


__device__ __forceinline__ void st16_sel(void* p, u32x4 v, bool wt) { if (wt) st16_wt(p, v); else *(u32x4*)p = v; }
namespace pg8 {
constexpr int BM = 256, BK = 64, HALF = 128, HTB = HALF * BK * 2  , STAGE_BYTES = 8 * HTB;
__device__ __forceinline__ int lds_byte(int r, int c) { const int st = (r >> 4) * 2 + (c >> 5), rr = r & 15, cc = c & 31, ob = rr * 64 + cc * 2; return st * 1024 + (ob ^ (((ob >> 9) & 1) << 5)); }
__device__ __forceinline__ void stage_rc(int b, int& R, int& Cc) { const int st = b / 1024, sb = b % 1024, swz = sb ^ (((sb >> 9) & 1) << 5); R = (st >> 1) * 16 + swz / 64; Cc = (st & 1) * 32 + (swz % 64) / 2; }
__device__ __forceinline__ int perm32(int rho) { const int n = rho >> 4, i = rho & 15; return 8 * (i >> 2) + 4 * n + (i & 3); }
struct Unit { int pm, pn, e, lt, cnt, row0; };
template <class Epi, class Sched>
__device__ __forceinline__ void gemm_phase(LAS unsigned char* lds, const int K, const Sched& S, const Epi& E, int tid) {
    const int wid = __builtin_amdgcn_readfirstlane(tid >> 6), lane = tid & 63, wr = wid >> 2, wc = wid & 3, fr = lane & 15, fq = lane >> 4;
    const int nt = K / BK;
    unsigned voffB[2], cva[2][2], nva[2][2]; int sR[2], sC[2];
#pragma unroll
    for (int i = 0; i < 2; ++i) { stage_rc(tid * 16 + i * 8192, sR[i], sC[i]); voffB[i] = (unsigned)(Epi::brow(sR[i]) * K + sC[i]) * 2u;
        cva[0][i] = cva[1][i] = nva[0][i] = nva[1][i] = (unsigned)(sR[i] * K + sC[i]) * 2u; }
    const size_t kstep = (size_t)(BK * 2);
    const size_t hstepA = Epi::GATHER ? (size_t)0 : (size_t)HALF * K * 2, hstepB = Epi::bstep(K);
#define PG8_GATHER(va, u) do { if constexpr (Epi::GATHER) { _Pragma("unroll") for (int h_ = 0; h_ < 2; ++h_) _Pragma("unroll") for (int i_ = 0; i_ < 2; ++i_) \
        va[h_][i_] = (unsigned)(E.arow(u, h_ * HALF + sR[i_]) * K + sC[i_]) * 2u; } } while (0)
    const unsigned ldsw = (unsigned)wid * 1024u;
    const int aoff = lds_byte(wr * 64 + fr, fq * 8), boff = lds_byte(wc * 32 + fr, fq * 8);
#define PG8_SA(b, h) (((b) * 2 + (h)) * HTB)
#define PG8_SB(b, h) ((4 + (b) * 2 + (h)) * HTB)
#define PG8_STAGE(bufoff, gbase, voff) do { _Pragma("unroll") for (int _i = 0; _i < 2; ++_i) \
        __builtin_amdgcn_global_load_lds((const unsigned*)((const char*)(gbase) + (voff)[_i]), (LAS unsigned*)(lds + (bufoff) + ldsw + _i * 8192), 16, 0, 0); } while (0)
#define PG8_LDA(dst, b, h) do { _Pragma("unroll") for (int m = 0; m < 4; ++m) _Pragma("unroll") for (int k = 0; k < 2; ++k) dst[m][k] = *(const LAS bf16x8*)(lds + PG8_SA(b, h) + aoff + m * 2048 + k * 1024); } while (0)
#define PG8_LDB(dst, b, h) do { _Pragma("unroll") for (int n = 0; n < 2; ++n) _Pragma("unroll") for (int k = 0; k < 2; ++k) dst[n][k] = *(const LAS bf16x8*)(lds + PG8_SB(b, h) + boff + n * 2048 + k * 1024); } while (0)
#define PG8_MMA(ai, bj, At, Bt) do { __builtin_amdgcn_s_setprio(1); _Pragma("unroll") for (int m = 0; m < 4; ++m) _Pragma("unroll") for (int n = 0; n < 2; ++n) _Pragma("unroll") for (int k = 0; k < 2; ++k) \
        acc[ai][bj][m][n] = __builtin_amdgcn_mfma_f32_16x16x32_bf16(Bt[n][k], At[m][k], acc[ai][bj][m][n], 0, 0, 0); __builtin_amdgcn_s_setprio(0); } while (0)
#define PG8_WAIT_V(n) asm volatile("s_waitcnt vmcnt(" #n ")" ::: "memory")
#define PG8_WAIT_L(n) asm volatile("s_waitcnt lgkmcnt(" #n ")" ::: "memory")
#define PG8_BAR __builtin_amdgcn_s_barrier()
#define PG8_SCHED __builtin_amdgcn_sched_barrier(0)
    Unit cur, nxt, nn; int ui = 0;
    if (!S.next(0, cur)) return;
    bool has_next = S.next(1, nxt);
    int prow[2][2] = {{0, 0}, {0, 0}};
#define PG8_ROWS(u) do { if constexpr (Epi::GATHER) { _Pragma("unroll") for (int h_ = 0; h_ < 2; ++h_) _Pragma("unroll") for (int i_ = 0; i_ < 2; ++i_) prow[h_][i_] = E.arow(u, h_ * HALF + sR[i_]); } } while (0)
    f32x4 acc[2][2][4][2];
    E.init(acc, cur, wr, wc, fr, fq);
    bf16x8 At[4][2], B0[2][2], B1[2][2];
    const char* cA = E.A(cur); const char* cB = E.B(cur);
    PG8_GATHER(cva, cur);
    if (has_next) PG8_ROWS(nxt);
    PG8_STAGE(PG8_SB(0, 0), cB, voffB); PG8_STAGE(PG8_SA(0, 0), cA, cva[0]); PG8_STAGE(PG8_SB(0, 1), cB + hstepB, voffB); PG8_STAGE(PG8_SA(0, 1), cA + hstepA, cva[1]);
    if (wr == 1) PG8_BAR;
    PG8_WAIT_V(4); PG8_BAR;
    PG8_STAGE(PG8_SB(1, 0), cB + kstep, voffB); PG8_STAGE(PG8_SA(1, 0), cA + kstep, cva[0]); PG8_STAGE(PG8_SB(1, 1), cB + hstepB + kstep, voffB);
    PG8_WAIT_V(6); PG8_BAR;
    for (;;) {
        const char* nA = has_next ? E.A(nxt) : cA; const char* nB = has_next ? E.B(nxt) : cB;
        if constexpr (Epi::GATHER) { if (has_next) { _Pragma("unroll") for (int h_ = 0; h_ < 2; ++h_) _Pragma("unroll") for (int i_ = 0; i_ < 2; ++i_) nva[h_][i_] = (unsigned)(prow[h_][i_] * K + sC[i_]) * 2u; } }
        const bool has_nn = has_next && S.next(ui + 2, nn);
        if (has_nn) PG8_ROWS(nn);
        for (int t = 0; t < nt; t += 2) {
            const bool last = (t == nt - 2);
            const char* a1 = cA + (size_t)(t + 1) * kstep;
            const char* a2 = last ? nA : cA + (size_t)(t + 2) * kstep; const char* b2 = last ? nB : cB + (size_t)(t + 2) * kstep;
            const char* a3 = a2 + kstep; const char* b3 = b2 + kstep;
            unsigned va0[2], va1[2];
#pragma unroll
            for (int i_ = 0; i_ < 2; ++i_) { va0[i_] = last ? nva[0][i_] : cva[0][i_]; va1[i_] = last ? nva[1][i_] : cva[1][i_]; }
            PG8_LDB(B0, 0, 0); PG8_SCHED; PG8_LDA(At, 0, 0); PG8_STAGE(PG8_SA(1, 1), a1 + hstepA, cva[1]);
            PG8_WAIT_L(8); PG8_BAR; PG8_WAIT_L(0); PG8_MMA(0, 0, At, B0); PG8_BAR; PG8_SCHED;
            PG8_LDB(B1, 0, 1); PG8_STAGE(PG8_SB(0, 0), b2, voffB);
            PG8_BAR; PG8_WAIT_L(0); PG8_MMA(0, 1, At, B1); PG8_BAR;
            PG8_LDA(At, 0, 1); PG8_STAGE(PG8_SA(0, 0), a2, va0);
            PG8_BAR; PG8_WAIT_L(0); PG8_MMA(1, 0, At, B0); PG8_BAR; PG8_SCHED;
            PG8_STAGE(PG8_SB(0, 1), b2 + hstepB, voffB);
            PG8_WAIT_V(6); PG8_BAR; PG8_MMA(1, 1, At, B1); PG8_BAR;
            PG8_LDB(B0, 1, 0); PG8_SCHED; PG8_LDA(At, 1, 0); PG8_STAGE(PG8_SA(0, 1), a2 + hstepA, va1);
            PG8_WAIT_L(8); PG8_BAR; PG8_WAIT_L(0); PG8_MMA(0, 0, At, B0); PG8_BAR; PG8_SCHED;
            PG8_LDB(B1, 1, 1); PG8_STAGE(PG8_SB(1, 0), b3, voffB);
            PG8_BAR; PG8_WAIT_L(0); PG8_MMA(0, 1, At, B1); PG8_BAR;
            PG8_LDA(At, 1, 1); PG8_STAGE(PG8_SA(1, 0), a3, va0);
            PG8_BAR; PG8_WAIT_L(0); PG8_MMA(1, 0, At, B0); PG8_BAR; PG8_SCHED;
            PG8_STAGE(PG8_SB(1, 1), b3 + hstepB, voffB);
            PG8_WAIT_V(6); PG8_BAR; PG8_MMA(1, 1, At, B1); PG8_BAR;
        }
        E(acc, cur, wr, wc, fr, fq, !has_next);
        if (!has_next) break;
        E.init(acc, nxt, wr, wc, fr, fq);
        cur = nxt; nxt = nn; has_next = has_nn; cA = nA; cB = nB; ++ui;
#pragma unroll
        for (int h_ = 0; h_ < 2; ++h_)
#pragma unroll
            for (int i_ = 0; i_ < 2; ++i_) cva[h_][i_] = nva[h_][i_];
    }
    PG8_WAIT_V(0);
    if (wr == 0) PG8_BAR;
    PG8_BAR;
#undef PG8_GATHER
#undef PG8_ROWS
#undef PG8_SA
#undef PG8_SB
#undef PG8_STAGE
#undef PG8_LDA
#undef PG8_LDB
#undef PG8_MMA
#undef PG8_WAIT_V
#undef PG8_WAIT_L
#undef PG8_BAR
#undef PG8_SCHED
}
}

template <int NCOL>
__device__ __forceinline__ void proj_epi(const Ctx& C, int layer, int seg, int tok, f32x16 x1, f32x16 x2, int hi, char* wbuf, int srow, int scol) {
    const float* cs = WSP(float, WS_ROPE); const float* sn = cs + SEQ * 32;
    bool rms, rope; const float* g = C.in[12];
    if (layer == 0) { rms = (seg >= 8 && seg < 16) || seg == 32 || seg == 33; rope = seg < 24 || seg == 32 || seg == 33; g = C.in[12] + (seg < 16 ? 0 : 64); }
    else { rms = false; rope = seg < 8 || seg == 16 || seg == 17; }
    const float qs = seg < 16 ? C2 : 1.f;
    const int b = tok / SP, t = tok - b * SP;
    if (rms) {
        float ss = 0.f;
#pragma unroll
        for (int r = 0; r < 16; ++r) ss += x1[r] * x1[r] + x2[r] * x2[r];
        ss = swap_add(ss);
        const float rinv = rsqrtf(ss * (1.f / 64.f) + 1e-6f);
#pragma unroll
        for (int g4 = 0; g4 < 4; ++g4) {
            const f32x4 g1 = *(const f32x4*)(g + 8 * g4 + 4 * hi), g2 = *(const f32x4*)(g + 32 + 8 * g4 + 4 * hi);
#pragma unroll
            for (int i = 0; i < 4; ++i) { x1[4 * g4 + i] *= rinv * g1[i]; x2[4 * g4 + i] *= rinv * g2[i]; }
        }
    }
    if (rope && t < SEQ) {
#pragma unroll
        for (int g4 = 0; g4 < 4; ++g4) {
            const f32x4 cc = *(const f32x4*)(cs + t * 32 + 8 * g4 + 4 * hi), ssn = *(const f32x4*)(sn + t * 32 + 8 * g4 + 4 * hi);
#pragma unroll
            for (int i = 0; i < 4; ++i) { const float a = x1[4 * g4 + i], bb = x2[4 * g4 + i]; x1[4 * g4 + i] = a * cc[i] - bb * ssn[i]; x2[4 * g4 + i] = bb * cc[i] + a * ssn[i]; }
        }
    }
    if (layer == 0 && rope) {
        float n2 = 0.f;
#pragma unroll
        for (int r = 0; r < 16; ++r) n2 += x1[r] * x1[r] + x2[r] * x2[r];
        n2 = swap_add(n2) * (qs * qs);
#pragma unroll
        for (int m = 16; m >= 1; m >>= 1) n2 = fmaxf(n2, __shfl_xor(n2, m));
        if (C.lane == 0) atomicMax((unsigned*)(C.ws + WS_CTL) + CW_NORM + b * 36 + seg, __float_as_uint(n2));
    }
#pragma unroll
    for (int g4 = 0; g4 < 4; ++g4) {
        u32x2 o1, o2;
        o1.x = cvtpk(x1[4 * g4] * qs, x1[4 * g4 + 1] * qs); o1.y = cvtpk(x1[4 * g4 + 2] * qs, x1[4 * g4 + 3] * qs);
        o2.x = cvtpk(x2[4 * g4] * qs, x2[4 * g4 + 1] * qs); o2.y = cvtpk(x2[4 * g4 + 2] * qs, x2[4 * g4 + 3] * qs);
        stage_put<NCOL>(wbuf, srow, scol + 8 * g4 + 4 * hi, o1); stage_put<NCOL>(wbuf, srow, scol + 32 + 8 * g4 + 4 * hi, o2);
    }
}
template <int NMI>
__device__ __forceinline__ void proj_tile(const Ctx& C, int layer, int tt, int nt  ) {
    const int tid = C.tid, lane = C.lane, wid = C.wid, r32 = lane & 31, hi = lane >> 5, wn = wid >> 2, wt = wid & 3;
    const bf16_t* Wt = WSP(bf16_t, WS_WIN) + (size_t)layer * NQKV * D;
    const bf16_t* act = WSP(bf16_t, WS_ACT);
    const int c = GEMM_SRC_CHUNK(tid), r0 = tid >> 3;
    const bf16_t* rp[NMI + 4];
#pragma unroll
    for (int i = 0; i < NMI; ++i) rp[i] = Wt + (size_t)(nt * NMI * 64 + r0 + 64 * i) * D + c * 8;
#pragma unroll
    for (int i = 0; i < 4; ++i) rp[NMI + i] = act + (size_t)(tt * 256 + r0 + 64 * i) * D + c * 8;
    f32x16 acc[NMI][2];
    gemm_core<16, NMI>(C.lds, rp, acc, tid);
    char* wbuf = C.lds + wid * WStage<NMI * 32>::BYTES;
#pragma unroll
    for (int hd = 0; hd < NMI / 2; ++hd) {
        const int seg = ((nt * NMI * 64 + wn * NMI * 32) >> 6) + hd;
#pragma unroll
        for (int ti = 0; ti < 2; ++ti) proj_epi<NMI * 32>(C, layer, seg, tt * 256 + wt * 64 + ti * 32 + r32, acc[2 * hd][ti], acc[2 * hd + 1][ti], hi, wbuf, ti * 32 + r32, hd * 64);
    }
    stage_flush<NMI * 32>(wbuf, lane, WSP(bf16_t, WS_QKV) + (size_t)(tt * 256 + wt * 64) * NQKV + nt * NMI * 64 + wn * NMI * 32, NQKV, 64);
    __syncthreads();
}
struct ProjOrder { int vcu, nblk, full; __device__ __forceinline__ bool next(int i, pg8::Unit& u) const { const int w = i * nblk + vcu; if (w >= full) return false; u.pm = w / (NQKV / 256); u.pn = w % (NQKV / 256); return true; } };
struct EpiProj {
    static constexpr bool GATHER = false;
    static __device__ __forceinline__ size_t bstep(int K) { return (size_t)32 * K * 2; }
    static __device__ __forceinline__ int brow(int R) { return (R >> 5) * 64 + pg8::perm32(R & 31); }
    unsigned char* ws; const float* gn; int layer; const bf16_t* W;
    __device__ __forceinline__ const char* A(const pg8::Unit& u) const { return (const char*)(ws + WS_ACT) + (size_t)u.pm * (256 * D * 2); }
    __device__ __forceinline__ const char* B(const pg8::Unit& u) const { return (const char*)W + (size_t)u.pn * (256 * D * 2); }
    __device__ __forceinline__ void init(f32x4 (&acc)[2][2][4][2], const pg8::Unit&, int, int, int, int) const {
#pragma unroll
        for (int a = 0; a < 2; ++a)
#pragma unroll
            for (int b = 0; b < 2; ++b)
#pragma unroll
                for (int m = 0; m < 4; ++m)
#pragma unroll
                    for (int n = 0; n < 2; ++n) acc[a][b][m][n] = (f32x4){0.f, 0.f, 0.f, 0.f};
    }
    __device__ __forceinline__ void operator()(const f32x4 (&acc)[2][2][4][2], const pg8::Unit& u, int wr, int wc, int fr, int fq, bool wt) const {
        const int seg = u.pn * 4 + wc;
        const float* cs = (const float*)(ws + WS_ROPE); const float* sn = cs + SEQ * 32;
        bool rms, rope; const float* g = gn;
        if (layer == 0) { rms = (seg >= 8 && seg < 16) || seg == 32 || seg == 33; rope = seg < 24 || seg == 32 || seg == 33; g = gn + (seg < 16 ? 0 : 64); }
        else { rms = false; rope = seg < 8 || seg == 16 || seg == 17; }
        const float qs = seg < 16 ? C2 : 1.f;
        f32x4 g1a = {1, 1, 1, 1}, g1b = g1a, g2a = g1a, g2b = g1a;
        if (rms) { g1a = *(const f32x4*)(g + 8 * fq); g1b = *(const f32x4*)(g + 8 * fq + 4); g2a = *(const f32x4*)(g + 32 + 8 * fq); g2b = *(const f32x4*)(g + 32 + 8 * fq + 4); }
        bf16_t* qkv = (bf16_t*)(ws + WS_QKV);
        float nmax = 0.f;
#pragma unroll
        for (int ai = 0; ai < 2; ++ai)
#pragma unroll
            for (int m = 0; m < 4; ++m) {
                const int tok = u.pm * 256 + ai * 128 + wr * 64 + m * 16 + fr;
                const int b = tok / SP, t = tok - b * SP;
                f32x4 x1a = acc[ai][0][m][0], x1b = acc[ai][0][m][1], x2a = acc[ai][1][m][0], x2b = acc[ai][1][m][1];
                if (rms) {
                    float ss = 0.f;
#pragma unroll
                    for (int i = 0; i < 4; ++i) ss += x1a[i] * x1a[i] + x1b[i] * x1b[i] + x2a[i] * x2a[i] + x2b[i] * x2b[i];
                    ss += __shfl_xor(ss, 16); ss += __shfl_xor(ss, 32);
                    const float rinv = rsqrtf(ss * (1.f / 64.f) + 1e-6f);
                    x1a *= rinv * g1a; x1b *= rinv * g1b; x2a *= rinv * g2a; x2b *= rinv * g2b;
                }
                if (rope && t < SEQ) {
                    const f32x4 ca = *(const f32x4*)(cs + t * 32 + 8 * fq), cb = *(const f32x4*)(cs + t * 32 + 8 * fq + 4), sa = *(const f32x4*)(sn + t * 32 + 8 * fq), sb = *(const f32x4*)(sn + t * 32 + 8 * fq + 4);
                    const f32x4 y1a = x1a * ca - x2a * sa, y2a = x2a * ca + x1a * sa, y1b = x1b * cb - x2b * sb, y2b = x2b * cb + x1b * sb;
                    x1a = y1a; x2a = y2a; x1b = y1b; x2b = y2b;
                }
                if (layer == 0 && rope) {
                    float n2 = 0.f;
#pragma unroll
                    for (int i = 0; i < 4; ++i) n2 += x1a[i] * x1a[i] + x1b[i] * x1b[i] + x2a[i] * x2a[i] + x2b[i] * x2b[i];
                    n2 += __shfl_xor(n2, 16); n2 += __shfl_xor(n2, 32); nmax = fmaxf(nmax, n2);
                }
                u32x4 o1, o2;
                o1.x = cvtpk(x1a[0] * qs, x1a[1] * qs); o1.y = cvtpk(x1a[2] * qs, x1a[3] * qs); o1.z = cvtpk(x1b[0] * qs, x1b[1] * qs); o1.w = cvtpk(x1b[2] * qs, x1b[3] * qs);
                o2.x = cvtpk(x2a[0] * qs, x2a[1] * qs); o2.y = cvtpk(x2a[2] * qs, x2a[3] * qs); o2.z = cvtpk(x2b[0] * qs, x2b[1] * qs); o2.w = cvtpk(x2b[2] * qs, x2b[3] * qs);
                bf16_t* rowp = qkv + (size_t)tok * NQKV + seg * 64 + 8 * fq;
                st16_sel(rowp, o1, wt); st16_sel(rowp + 32, o2, wt);
            }
        if (layer == 0 && rope) {
            nmax *= qs * qs;
#pragma unroll
            for (int mk = 8; mk >= 1; mk >>= 1) nmax = fmaxf(nmax, __shfl_xor(nmax, mk));
            if ((fr | fq) == 0) atomicMax((unsigned*)(ws + WS_CTL) + CW_NORM + ((u.pm * 256) / SP) * 36 + seg, __float_as_uint(nmax));
        }
    }
};
__device__ __forceinline__ void phase_proj(const Ctx& C, int layer) {
    constexpr int NTT = R / 256, NNT = NQKV / 256, TOT = NTT * NNT;
    const int full = (TOT / C.nblk) * C.nblk;
    {
        ProjOrder S; S.vcu = C.vcu; S.nblk = C.nblk; S.full = full;
        EpiProj E; E.ws = C.ws; E.gn = C.in[12]; E.layer = layer; E.W = WSP(bf16_t, WS_WIN) + (size_t)layer * NQKV * D;
        pg8::gemm_phase((LAS unsigned char*)C.lds, D, S, E, C.tid);
    }
    for (int w2 = C.bid; w2 < 2 * (TOT - full); w2 += C.nblk) {
        const int w = full + (w2 >> 1);
        proj_tile<2>(C, layer, w / NNT, 2 * (w % NNT) + (w2 & 1));
    }
}

__device__ __forceinline__ void attn0_diff(const Ctx& C, int b, int hc, int q0, int kstart, int nt) {
    const attn128::bf16* qkv = (const attn128::bf16*)(WSP(bf16_t, WS_QKV) + (size_t)b * SP * NQKV);
    const LAS unsigned* nrm = (const LAS unsigned*)(LAS char*)(C.lds + NORM_LDS) + b * 36;
    const float qn = sqrtf(__uint_as_float(__builtin_amdgcn_readfirstlane(nrm[hc]))), kmaxs = sqrtf(__uint_as_float(__builtin_amdgcn_readfirstlane(nrm[16 + hc]))) * 1.02f;
    if (qn * kmaxs < 60.f)
        attn128::attn_unit<8, true>(qkv + (size_t)q0 * NQKV + hc * 64, qkv + (size_t)kstart * NQKV + 1024 + hc * 64, qkv + (size_t)kstart * NQKV + 1536 + (hc >> 1) * 128,
                                    (attn128::bf16*)(WSP(bf16_t, WS_AO) + ((size_t)b * SP + q0) * D + hc * 128), NQKV, D, nt, C.lds, kmaxs);
    else
        attn128::attn_unit<8>(qkv + (size_t)q0 * NQKV + hc * 64, qkv + (size_t)kstart * NQKV + 1024 + hc * 64, qkv + (size_t)kstart * NQKV + 1536 + (hc >> 1) * 128,
                              (attn128::bf16*)(WSP(bf16_t, WS_AO) + ((size_t)b * SP + q0) * D + hc * 128), NQKV, D, nt, C.lds);
}
__device__ __forceinline__ void attn0_gqa(const Ctx& C, int b, int g, int q0, int kstart, int nt) {
    const attn_body::bf16* qkv = (const attn_body::bf16*)(WSP(bf16_t, WS_QKV) + (size_t)b * SP * NQKV);
    const LAS unsigned* nrm = (const LAS unsigned*)(LAS char*)(C.lds + NORM_LDS) + b * 36;
    const float qn = sqrtf(__uint_as_float(__builtin_amdgcn_readfirstlane(nrm[8 + g]))), kmaxs = sqrtf(__uint_as_float(__builtin_amdgcn_readfirstlane(nrm[32 + (g >> 2)]))) * 1.02f;
    if (qn * kmaxs < 60.f)
        attn_body::attn_unit<8, true>(qkv + (size_t)q0 * NQKV + 512 + g * 64, qkv + (size_t)kstart * NQKV + 2048 + (g >> 2) * 64, qkv + (size_t)kstart * NQKV + 2176 + (g >> 2) * 64,
                                      (attn_body::bf16*)(WSP(bf16_t, WS_ACT) + ((size_t)b * SP + q0) * D + 512 + g * 64), NQKV, D, nt, C.lds, kmaxs);
    else
        attn_body::attn_unit<8>(qkv + (size_t)q0 * NQKV + 512 + g * 64, qkv + (size_t)kstart * NQKV + 2048 + (g >> 2) * 64, qkv + (size_t)kstart * NQKV + 2176 + (g >> 2) * 64,
                                (attn_body::bf16*)(WSP(bf16_t, WS_ACT) + ((size_t)b * SP + q0) * D + 512 + g * 64), NQKV, D, nt, C.lds);
}
__device__ __forceinline__ void phase_attn0(const Ctx& C) {
    if (C.tid < 72) ((LAS unsigned*)(LAS char*)(C.lds + NORM_LDS))[C.tid] = xb_ld((unsigned*)(C.ws + WS_CTL) + CW_NORM + C.tid);
    __syncthreads();
    if (C.nblk & 7) {
        conv_tiles<true, 0>(C, CONV_EARLY + C.bid, C.nblk, CONV_TILES); __syncthreads();
        for (int u = C.bid; u < 1024; u += C.nblk) { const int sl = (u >> 5) & 15; if (u < 512) attn0_diff(C, sl >> 3, sl & 7, (u & 31) * 256, 0, SP / 64); else attn0_gqa(C, sl >> 3, sl & 7, (u & 31) * 256, 0, SP / 64); }
        for (int u = C.bid; u < 32; u += C.nblk) { if (u < 16) attn0_diff(C, u >> 3, u & 7, SEQ, SEQ, NCTX / 64); else attn0_gqa(C, (u - 16) >> 3, (u - 16) & 7, SEQ, SEQ, NCTX / 64); }
        return;
    }
    const int xcd = C.vcu / (C.nblk >> 3), jx = C.vcu % (C.nblk >> 3);
    const int nper = C.nblk >> 3;
    if (nper != 32) { __syncthreads(); conv_tiles<true, 0>(C, CONV_EARLY + C.bid, C.nblk, CONV_TILES); __syncthreads(); }
    const int cslot = nper == 32 ? jx % 5 : -1;
#pragma nounroll
    for (int stp = 0; stp < 5; ++stp) {
        if (stp == cslot) { __syncthreads(); conv_tiles<true, (CONV_TILES - CONV_EARLY) / 256>(C, CONV_EARLY + C.bid, 256, CONV_TILES); __syncthreads(); }
        if (stp < 2) { for (int u = jx + stp * nper; u < 64; u += 2 * nper) { const int sl = xcd * 2 + (u >> 5); attn0_diff(C, sl >> 3, sl & 7, (u & 31) * 256, 0, SP / 64); } }
        else if (stp < 4) { for (int u = jx + (stp - 2) * nper; u < 64; u += 2 * nper) { const int sl = xcd * 2 + (u >> 5); attn0_gqa(C, sl >> 3, sl & 7, (u & 31) * 256, 0, SP / 64); } }
    }
    for (int u = C.bid; u < 32; u += C.nblk) { if (u < 16) attn0_diff(C, u >> 3, u & 7, SEQ, SEQ, NCTX / 64); else attn0_gqa(C, (u - 16) >> 3, (u - 16) & 7, SEQ, SEQ, NCTX / 64); }
}

__device__ __forceinline__ void phase_attn1(const Ctx& C) {
    const LAS float* rpbL = (const LAS float*)(LAS char*)(C.lds + attn_msk::ATTN_LDS_BYTES);
    for (int it = 0;; ++it) {
        const int u = __builtin_amdgcn_readfirstlane(xcd_item(C, it)); if (u >= 1024) break;
        const int kind = u >> 9, v = u & 511, b = v >> 8, g = (v >> 5) & 7, q0 = (v & 31) * 256;
        const attn_msk::bf16* qkv = (const attn_msk::bf16*)(WSP(bf16_t, WS_QKV) + (size_t)b * SP * NQKV);
        attn_msk::bf16* op = (attn_msk::bf16*)(WSP(bf16_t, WS_ACT) + ((size_t)b * SP + q0) * D);
        if (kind == 0) {
            const int lo = q0 - 128 < 0 ? 0 : q0 - 128, hi_ = q0 + 384 > SEQ ? SEQ : q0 + 384;
            attn_msk::attn_unit<8, 1>(qkv + (size_t)q0 * NQKV + g * 64, qkv + 1024 + (g >> 2) * 64, qkv + 1152 + (g >> 2) * 64, op + g * 64, NQKV, D, 4 + (hi_ - lo) / 64, C.lds,
                                      q0, lo, 0, C.in[15][g] * LOG2E, rpbL);
        } else {
            const int gr = q0 >> 6, R0 = gr - 4 < 0 ? 0 : (gr - 4 > 120 ? 120 : gr - 4);
            int R1 = gr + 3 - 4; R1 = (R1 < 0 ? 0 : (R1 > 120 ? 120 : R1)) + 8;
            const int nrows = R1 - R0;
            __syncthreads();
            { int t_ = C.tid; asm volatile("" : "+v"(t_)); if (t_ < 465) ((float*)(C.lds + attn_msk::ATTN_LDS_BYTES))[t_] = C.in[16][g * 465 + t_] * LOG2E; }
            __syncthreads();
            attn_msk::attn_unit<8, 2>(qkv + (size_t)q0 * NQKV + 512 + g * 64, qkv + 1280 + g * 64, qkv + 1792 + g * 64, op + 512 + g * 64, NQKV, D, 4 + nrows + (nrows & 1), C.lds,
                                      q0, R0 * 64, nrows, 0.f, rpbL);
        }
    }
}

__device__ __forceinline__ void phase_merge0(const Ctx& C) {
    const int lane = C.lane;
    const float* lv = C.in[10];
    const float sa = wave_sum(lv[lane] * lv[64 + lane]), sb = wave_sum(lv[128 + lane] * lv[192 + lane]);
    const float lam = expf(sa) - expf(sb) + 0.2f;
    const float g0 = C.in[11][2 * lane], g1 = C.in[11][2 * lane + 1];
    const bf16_t* ao = WSP(bf16_t, WS_AO); bf16_t* act = WSP(bf16_t, WS_ACT);
    for (int row = C.bid * 8 + C.wid; row < R; row += C.nblk * 8) {
#pragma unroll
        for (int h = 0; h < 4; ++h) {
            const unsigned a = *(const unsigned*)(ao + (size_t)row * D + (h * 2) * 128 + 2 * lane), b = *(const unsigned*)(ao + (size_t)row * D + (h * 2 + 1) * 128 + 2 * lane);
            const float d0 = bf2f((unsigned short)(a & 0xffff)) - lam * bf2f((unsigned short)(b & 0xffff)), d1 = bf2f((unsigned short)(a >> 16)) - lam * bf2f((unsigned short)(b >> 16));
            const float ss = wave_sum(d0 * d0 + d1 * d1);
            const float rinv = rsqrtf(ss * (1.f / 128.f) + 1e-6f) * 0.8f;
            *(unsigned*)(act + (size_t)row * D + h * 128 + 2 * lane) = cvtpk(d0 * rinv * g0, d1 * rinv * g1);
        }
    }
}

template <int NMI>
__device__ __forceinline__ void out_tile(const Ctx& C, int layer, int tt, int nt) {
    const int tid = C.tid, lane = C.lane, wid = C.wid, r32 = lane & 31, hi = lane >> 5, wn = wid >> 2, wt = wid & 3;
    const bf16_t* Wt = WSP(bf16_t, WS_WG) + (size_t)(layer * 3 + row_set(tt * 256)) * D * D;
    const bf16_t* act = WSP(bf16_t, WS_ACT);
    float* H = WSP(float, WS_H);
    const int c = GEMM_SRC_CHUNK(tid), r0 = tid >> 3;
    const bf16_t* rp[NMI + 4];
#pragma unroll
    for (int i = 0; i < NMI; ++i) rp[i] = Wt + (size_t)(nt * NMI * 64 + r0 + 64 * i) * D + c * 8;
#pragma unroll
    for (int i = 0; i < 4; ++i) rp[NMI + i] = act + (size_t)(tt * 256 + r0 + 64 * i) * D + c * 8;
    const int n0 = nt * NMI * 64 + wn * NMI * 32;
    f32x16 acc[NMI][2];
#pragma unroll
    for (int ti = 0; ti < 2; ++ti) {
        const int tok = tt * 256 + wt * 64 + ti * 32 + r32;
        const float* hp = (layer == 0 ? hin_row(C, tok) : H + (size_t)tok * D) + n0 + 4 * hi;
#pragma unroll
        for (int mi = 0; mi < NMI; ++mi)
#pragma unroll
            for (int g4 = 0; g4 < 4; ++g4) {
                const f32x4 hv = *(const f32x4*)(hp + mi * 32 + 8 * g4);
                acc[mi][ti][4 * g4] = hv[0]; acc[mi][ti][4 * g4 + 1] = hv[1]; acc[mi][ti][4 * g4 + 2] = hv[2]; acc[mi][ti][4 * g4 + 3] = hv[3];
            }
    }
    gemm_core<16, NMI, false, true>(C.lds, rp, acc, tid);
    constexpr int NC = NMI * 32, P = NC * 4 + 16, CH = NC / 4;
    char* wbuf = C.lds + wid * (32 * P);
#pragma unroll
    for (int ti = 0; ti < 2; ++ti) {
#pragma unroll
        for (int mi = 0; mi < NMI; ++mi)
#pragma unroll
            for (int g4 = 0; g4 < 4; ++g4) {
                f32x4 v; v[0] = ALPHA * acc[mi][ti][4 * g4]; v[1] = ALPHA * acc[mi][ti][4 * g4 + 1]; v[2] = ALPHA * acc[mi][ti][4 * g4 + 2]; v[3] = ALPHA * acc[mi][ti][4 * g4 + 3];
                *(f32x4*)(wbuf + r32 * P + (mi * 32 + 8 * g4 + 4 * hi) * 4) = v;
            }
        __builtin_amdgcn_sched_barrier(0);
#pragma unroll
        for (int i = 0; i < CH / 2; ++i) {
            if ((i & 3) == 0) __builtin_amdgcn_sched_barrier(0);
            const int idx = i * 64 + lane, row = idx / CH, ch = idx % CH;
            const int tok = tt * 256 + wt * 64 + ti * 32 + row;
            const u32x4 a = *(const u32x4*)(wbuf + row * P + ch * 16);
            st16_wt(H + (size_t)tok * D + n0 + ch * 4, a);
        }
        __builtin_amdgcn_sched_barrier(0);
    }
    __syncthreads();
}
struct OutOrder { int vcu, nblk, full, layer; __device__ __forceinline__ bool next(int i, pg8::Unit& u) const { const int w = i * nblk + vcu; if (w >= full) return false;
    int tt = w / (D / 256); if (layer != 0) tt = tt < 32 ? tt : tt + 1; u.pm = tt; u.pn = w % (D / 256); return true; } };
struct EpiOut {
    static constexpr bool GATHER = false;
    static __device__ __forceinline__ size_t bstep(int K) { return (size_t)128 * K * 2; }
    static __device__ __forceinline__ int brow(int R) { return R; }
    unsigned char* ws; const float* x; const float* cx; int layer;
    __device__ __forceinline__ const char* A(const pg8::Unit& u) const { return (const char*)(ws + WS_ACT) + (size_t)u.pm * (256 * D * 2); }
    __device__ __forceinline__ const char* B(const pg8::Unit& u) const { return (const char*)((const bf16_t*)(ws + WS_WG) + (size_t)(layer * 3 + row_set(u.pm * 256)) * D * D) + (size_t)u.pn * (256 * D * 2); }
    __device__ __forceinline__ const float* hrow(int row) const {
        if (layer != 0) return (const float*)(ws + WS_H) + (size_t)row * D;
        const int b = row / SP, t = row - b * SP;
        return t < SEQ ? x + ((size_t)b * SEQ + t) * D : cx + ((size_t)b * NCTX + (t - SEQ)) * D;
    }
    __device__ __forceinline__ void init(f32x4 (&acc)[2][2][4][2], const pg8::Unit& u, int wr, int wc, int fr, int fq) const {
#pragma unroll
        for (int ai = 0; ai < 2; ++ai)
#pragma unroll
            for (int m = 0; m < 4; ++m) { const float* hp = hrow(u.pm * 256 + ai * 128 + wr * 64 + m * 16 + fr) + u.pn * 256 + wc * 32 + 4 * fq;
#pragma unroll
                for (int bj = 0; bj < 2; ++bj)
#pragma unroll
                    for (int n = 0; n < 2; ++n) acc[ai][bj][m][n] = *(const f32x4*)(hp + bj * 128 + n * 16); }
    }
    __device__ __forceinline__ void operator()(const f32x4 (&acc)[2][2][4][2], const pg8::Unit& u, int wr, int wc, int fr, int fq, bool wt) const {
        float* H = (float*)(ws + WS_H);
#pragma unroll
        for (int ai = 0; ai < 2; ++ai)
#pragma unroll
            for (int m = 0; m < 4; ++m) { float* rowp = H + (size_t)(u.pm * 256 + ai * 128 + wr * 64 + m * 16 + fr) * D + u.pn * 256 + wc * 32 + 4 * fq;
#pragma unroll
                for (int bj = 0; bj < 2; ++bj)
#pragma unroll
                    for (int n = 0; n < 2; ++n) { const f32x4 o = ALPHA * acc[ai][bj][m][n]; st16_sel(rowp + bj * 128 + n * 16, __builtin_bit_cast(u32x4, o), wt); } }
    }
};
__device__ __forceinline__ void phase_out(const Ctx& C, int layer) {
    constexpr int NNT = D / 256;
    const int NTT = layer == 0 ? R / 256 : 2 * (SEQ / 256), TOT = NTT * NNT;
    const int full = (TOT / C.nblk) * C.nblk;
    {
        OutOrder S; S.vcu = C.vcu; S.nblk = C.nblk; S.full = full; S.layer = layer;
        EpiOut E; E.ws = C.ws; E.x = C.in[0]; E.cx = C.in[2]; E.layer = layer;
        pg8::gemm_phase((LAS unsigned char*)C.lds, D, S, E, C.tid);
    }
    for (int w2 = C.bid; w2 < 2 * (TOT - full); w2 += C.nblk) {
        const int w = full + (w2 >> 1);
        int tt = w / NNT; if (layer != 0) tt = tt < 32 ? tt : tt + 1;
        out_tile<2>(C, layer, tt, 2 * (w % NNT) + (w2 & 1));
    }
}

__device__ __forceinline__ int moe_row(int layer, int tok) { return layer == 0 ? tok : (tok >> 13) * SP + (tok & 8191); }
__device__ __forceinline__ void phase_route(const Ctx& C, int layer) {
    const int tid = C.tid, lane = C.lane, wid = C.wid;
    float* Wl = (float*)C.lds;
    int* se0 = (int*)(C.lds + 147456); int* se1 = se0 + 128; float* sw0 = (float*)(se1 + 128); float* sw1 = sw0 + 128;
    int* cnt = (int*)(sw1 + 128); int* base = cnt + 32; int* sl0 = base + 32; int* sl1 = sl0 + 128;
    float* smu = (float*)(sl1 + 128); float* srs = smu + 128;
    const float* wg = C.in[17] + (size_t)layer * D * 4; const float* wr = C.in[19] + (size_t)layer * D * 32;
    {
        static_assert(D * 9 == 18 * NTHR, "router table fill");
        f32x4 tv[18];
#pragma unroll
        for (int j = 0; j < 18; ++j) { const int i = tid + j * NTHR, k = i / 9, q = i - k * 9; const float* p = q == 0 ? wg + k * 4 : wr + k * 32 + (q - 1) * 4; tv[j] = *(const f32x4*)p; }
#pragma unroll
        for (int j = 0; j < 18; ++j) { const int i = tid + j * NTHR, k = i / 9, q = i - k * 9; *(f32x4*)(Wl + (((k & 3) << 8) + (k >> 2)) * 36 + q * 4) = tv[j]; }
    }
    const int T = layer == 0 ? R : NB * SEQ;
    const int chunk = (T + C.nblk - 1) / C.nblk;
    const int c0_ = C.bid * chunk, c1_ = c0_ + chunk < T ? c0_ + chunk : T;
  for (int t0 = c0_; t0 < c1_; t0 += 128) {
    const int t1 = t0 + 128 < c1_ ? t0 + 128 : c1_;
    __syncthreads();
    if (tid < 32) cnt[tid] = 0;
    __syncthreads();
    float* H = WSP(float, WS_H); bf16_t* act = WSP(bf16_t, WS_ACT);
    const float* lng = C.in[6] + (size_t)(layer * 2 + 0) * D; const float* lnb = C.in[7] + (size_t)(layer * 2 + 0) * D;
    const float* bg = C.in[18] + layer * 4; const float* br = C.in[20] + layer * 32;
    f32x4 xn[4];
    if (t0 + wid < t1) {
        const float* hn = H + (size_t)moe_row(layer, t0 + wid) * D;
#pragma unroll
        for (int i = 0; i < 4; ++i) xn[i] = *(const f32x4*)(hn + lane * 4 + 256 * i);
    }
    for (int tk = t0 + wid; tk < t1; tk += 8) {
        const int row = moe_row(layer, tk);
        const float* m = WSP(float, WS_MODS) + (size_t)(layer * 3 + row_set(row)) * 6144;
        float* hr = H + (size_t)row * D;
        f32x4 x[4]; float s = 0.f, q = 0.f;
#pragma unroll
        for (int i = 0; i < 4; ++i) { x[i] = xn[i]; s += (x[i][0] + x[i][1]) + (x[i][2] + x[i][3]); q += (x[i][0] * x[i][0] + x[i][1] * x[i][1]) + (x[i][2] * x[i][2] + x[i][3] * x[i][3]); }
        if (tk + 8 < t1) {
            const float* hn = H + (size_t)moe_row(layer, tk + 8) * D;
#pragma unroll
            for (int i = 0; i < 4; ++i) xn[i] = *(const f32x4*)(hn + lane * 4 + 256 * i);
        }
        wave_sum2(s, q, lane);
        const float mean = s * (1.f / 1024.f);
        const float rstd = rsqrtf(fmaxf(q * (1.f / 1024.f) - mean * mean, 0.f) + 1e-5f);
#pragma unroll
        for (int i = 0; i < 4; ++i) x[i] -= mean;
        f32x4 f[4]; u32x2 ob[4];
#pragma unroll
        for (int i = 0; i < 4; ++i) {
            const int col = lane * 4 + 256 * i;
            const f32x4 g = *(const f32x4*)(lng + col), bb = *(const f32x4*)(lnb + col);
            const f32x4 hv = x[i] * rstd * g + bb;
            const f32x4 sh = *(const f32x4*)(m + 3 * 1024 + col), sc = *(const f32x4*)(m + 4 * 1024 + col);
            f[i] = hv * (1.f + sc) + sh;
            ob[i].x = cvtpk(f[i][0], f[i][1]); ob[i].y = cvtpk(f[i][2], f[i][3]);
        }
        store_row_bf16(act + (size_t)row * D, lane, ob);
        f32x4 gl = {0, 0, 0, 0};
#pragma unroll
        for (int i = 0; i < 4; ++i)
#pragma unroll
            for (int cc = 0; cc < 4; ++cc) gl += f[i][cc] * *(const f32x4*)(Wl + (cc * 256 + 64 * i + lane) * 36);
        gl = wave_sum4(gl, lane);
        const float g0 = gl[0] + bg[0], g1 = gl[1] + bg[1], g2 = gl[2] + bg[2], g3 = gl[3] + bg[3];
        int gi = 0; float gm = g0;
        if (g1 > gm) { gm = g1; gi = 1; } if (g2 > gm) { gm = g2; gi = 2; } if (g3 > gm) { gm = g3; gi = 3; }
        const float gw = 1.f / (expf(g0 - gm) + expf(g1 - gm) + expf(g2 - gm) + expf(g3 - gm));
        f32x4 ea = {0, 0, 0, 0}, eb = ea;
#pragma unroll
        for (int i = 0; i < 4; ++i)
#pragma unroll
            for (int cc = 0; cc < 4; ++cc) {
                const float* wp = Wl + (cc * 256 + 64 * i + lane) * 36 + 4 + 8 * gi;
                ea += f[i][cc] * *(const f32x4*)(wp); eb += f[i][cc] * *(const f32x4*)(wp + 4);
            }
        float ev[8];
        wave_sum8(ea, eb, ev, lane);
#pragma unroll
        for (int k = 0; k < 8; ++k) ev[k] += br[gi * 8 + k];
        int i0 = 0; float v0 = ev[0];
#pragma unroll
        for (int k = 1; k < 8; ++k) if (ev[k] > v0) { v0 = ev[k]; i0 = k; }
        int i1 = -1; float v1 = -3.0e38f;
#pragma unroll
        for (int k = 0; k < 8; ++k) if (k != i0 && ev[k] > v1) { v1 = ev[k]; i1 = k; }
        const float e = expf(v1 - v0);
        if (lane == 0) { const int li = tk - t0; se0[li] = gi * 8 + i0; se1[li] = gi * 8 + i1; sw0[li] = gw / (1.f + e); sw1[li] = gw * e / (1.f + e); smu[li] = mean; srs[li] = rstd; }
    }
    __syncthreads();
    const int nloc = t1 - t0;
    if (tid < 2 * nloc) { const int li = tid >> 1; const int e = (tid & 1) ? se1[li] : se0[li]; const int s = atomicAdd(&cnt[e], 1); if (tid & 1) sl1[li] = s; else sl0[li] = s; }
    __syncthreads();
    unsigned* gc = (unsigned*)(C.ws + WS_CTL) + CW_CNT + layer * 64;
    if (tid < 32) base[tid] = cnt[tid] > 0 ? (int)atomicAdd(&gc[tid], (unsigned)cnt[tid]) : 0;
    __syncthreads();
    int* perm = WSP(int, WS_PERM); int* tokinfo = WSP(int, WS_TOK);
    if (tid < nloc) {
        const int li = tid, row = moe_row(layer, t0 + li);
        const int e0 = se0[li], e1 = se1[li], s0 = base[e0] + sl0[li], s1 = base[e1] + sl1[li];
        perm[e0 * CAP + s0] = row; perm[e1 * CAP + s1] = row;
        int* ti = tokinfo + (size_t)row * 8;
        ti[0] = e0; ti[1] = s0; ti[2] = e1; ti[3] = s1; ti[4] = __float_as_int(sw0[li]); ti[5] = __float_as_int(sw1[li]); ti[6] = __float_as_int(smu[li]); ti[7] = __float_as_int(srs[li]);
    }
  }
    __syncthreads();
}

struct MoeTab { int* cnt; int* off; int* tp; };
__device__ __forceinline__ MoeTab moe_tables(const Ctx& C, int layer, int ldsoff, bool build = true) {
    MoeTab M; M.cnt = (int*)(C.lds + ldsoff); M.off = M.cnt + 32; M.tp = M.off + 33;
    if (MK_SINGLE && !build) return M;
    __syncthreads();
    if (C.wid == 0) {
        const int lane = C.lane;
        unsigned* gc = (unsigned*)(C.ws + WS_CTL) + CW_CNT + layer * 64;
        const int c = lane < 32 ? (int)__hip_atomic_load(&gc[lane], __ATOMIC_RELAXED, __HIP_MEMORY_SCOPE_AGENT) : 0;
        const int tl = (c + 255) >> 8;
        int o = c, t = tl;
#pragma unroll
        for (int d = 1; d < 32; d <<= 1) { const int o2 = __shfl_up(o, d), t2 = __shfl_up(t, d); if (lane >= d) { o += o2; t += t2; } }
        if (lane < 32) { M.cnt[lane] = c; M.off[lane] = o - c; M.tp[lane] = t - tl; }
        if (lane == 31) { M.off[32] = o; M.tp[32] = t; }
    }
    __syncthreads();
    return M;
}

template <int NMI>
__device__ __forceinline__ void moe1_tile(const Ctx& C, int layer, const MoeTab& M, int ttile, int nt  ) {
    const int tid = C.tid, lane = C.lane, wid = C.wid, r32 = lane & 31, hi = lane >> 5, wn = wid >> 2, wt = wid & 3;
    const bf16_t* act = WSP(bf16_t, WS_ACT); const int* perm = WSP(int, WS_PERM);
    bf16_t* hb = WSP(bf16_t, WS_HB);
    const int c = GEMM_SRC_CHUNK(tid), r0 = tid >> 3;
    int e = 0;
    for (int k = 1; k < 32; ++k) if (M.tp[k] <= ttile) e = k;
    const int lt = ttile - M.tp[e], cnt = M.cnt[e];
    const bf16_t* rp[NMI + 4];
#pragma unroll
    for (int i = 0; i < NMI; ++i) {
        const int r = r0 + 64 * i, wn_ = r / (NMI * 32), mi = (r >> 5) % NMI, rr = r & 31;
        const bf16_t* Wb = (mi / (NMI / 2)) ? WSP(bf16_t, WS_W3) : WSP(bf16_t, WS_W1);
        rp[i] = Wb + ((size_t)(layer * 32 + e) * 512 + nt * (NMI * 32) + wn_ * (NMI * 16) + (mi % (NMI / 2)) * 32 + rr) * D + c * 8;
    }
#pragma unroll
    for (int i = 0; i < 4; ++i) {
        int slot = lt * 256 + r0 + 64 * i; slot = slot < cnt ? slot : cnt - 1;
        rp[NMI + i] = act + (size_t)perm[e * CAP + slot] * D + c * 8;
    }
    f32x16 acc[NMI][2];
    gemm_core<16, NMI, true>(C.lds, rp, acc, tid, cnt - lt * 256 < 256 ? cnt - lt * 256 : 256);
    char* wbuf = C.lds + wid * WStage<NMI * 16>::BYTES;
#pragma unroll
    for (int ti = 0; ti < 2; ++ti)
#pragma unroll
        for (int p = 0; p < NMI / 2; ++p)
#pragma unroll
            for (int g4 = 0; g4 < 4; ++g4) {
                float hv[4];
#pragma unroll
                for (int i = 0; i < 4; ++i) hv[i] = silu_f(acc[p][ti][4 * g4 + i]) * acc[p + NMI / 2][ti][4 * g4 + i];
                u32x2 o; o.x = cvtpk(hv[0], hv[1]); o.y = cvtpk(hv[2], hv[3]);
                stage_put<NMI * 16>(wbuf, ti * 32 + r32, p * 32 + 8 * g4 + 4 * hi, o);
            }
    stage_flush<NMI * 16>(wbuf, lane, hb + (size_t)(M.off[e] + lt * 256 + wt * 64) * 512 + nt * (NMI * 32) + wn * (NMI * 16), 512, cnt - (lt * 256 + wt * 64));
    __syncthreads();
}
struct MoeOrder { int vcu, nblk, full; const int* tp; const int* cnt; const int* off;
    __device__ __forceinline__ bool next(int i, pg8::Unit& u) const { const int w = i * nblk + vcu; if (w >= full) return false;
        const int tt = w >> 2; int e = 0;
        for (int k = 1; k < 32; ++k) if (tp[k] <= tt) e = k;
        e = __builtin_amdgcn_readfirstlane(e);
        u.pm = tt; u.pn = w & 3; u.e = e; u.lt = tt - __builtin_amdgcn_readfirstlane(tp[e]); u.cnt = __builtin_amdgcn_readfirstlane(cnt[e]); u.row0 = __builtin_amdgcn_readfirstlane(off[e]) + u.lt * 256; return true; } };
struct EpiMoe1 {
    static constexpr bool GATHER = true;
    static __device__ __forceinline__ size_t bstep(int) { return WS_W3 - WS_W1; }
    static __device__ __forceinline__ int brow(int R) { return (R & ~31) + pg8::perm32(R & 31); }
    unsigned char* ws; int layer;
    __device__ __forceinline__ const char* A(const pg8::Unit&) const { return (const char*)(ws + WS_ACT); }
    __device__ __forceinline__ int arow(const pg8::Unit& u, int r) const { int slot = u.lt * 256 + r; slot = slot < u.cnt ? slot : u.cnt - 1; return ((const int*)(ws + WS_PERM))[u.e * CAP + slot]; }
    __device__ __forceinline__ const char* B(const pg8::Unit& u) const { return (const char*)(ws + WS_W1) + ((size_t)(layer * 32 + u.e) * 512 + u.pn * 128) * (D * 2); }
    __device__ __forceinline__ void init(f32x4 (&acc)[2][2][4][2], const pg8::Unit&, int, int, int, int) const {
#pragma unroll
        for (int a = 0; a < 2; ++a)
#pragma unroll
            for (int b = 0; b < 2; ++b)
#pragma unroll
                for (int m = 0; m < 4; ++m)
#pragma unroll
                    for (int n = 0; n < 2; ++n) acc[a][b][m][n] = (f32x4){0.f, 0.f, 0.f, 0.f};
    }
    __device__ __forceinline__ void operator()(const f32x4 (&acc)[2][2][4][2], const pg8::Unit& u, int wr, int wc, int fr, int fq, bool wt) const {
        bf16_t* hb = (bf16_t*)(ws + WS_HB);
        const int nval = u.cnt - u.lt * 256;
#pragma unroll
        for (int ai = 0; ai < 2; ++ai)
#pragma unroll
            for (int m = 0; m < 4; ++m) { const int r = ai * 128 + wr * 64 + m * 16 + fr;
                if (r < nval) {
                    const f32x4 a0 = acc[ai][0][m][0], a1 = acc[ai][0][m][1], b0 = acc[ai][1][m][0], b1 = acc[ai][1][m][1];
                    u32x4 w; w.x = cvtpk(silu_f(a0[0]) * b0[0], silu_f(a0[1]) * b0[1]); w.y = cvtpk(silu_f(a0[2]) * b0[2], silu_f(a0[3]) * b0[3]);
                    w.z = cvtpk(silu_f(a1[0]) * b1[0], silu_f(a1[1]) * b1[1]); w.w = cvtpk(silu_f(a1[2]) * b1[2], silu_f(a1[3]) * b1[3]);
                    st16_sel(hb + (size_t)(u.row0 + r) * 512 + u.pn * 128 + wc * 32 + 8 * fq, w, wt); } }
    }
};
__device__ __forceinline__ void phase_moe1(const Ctx& C, int layer) {
    const MoeTab M = moe_tables(C, layer, GEMM_LDS);
    const int TOT = M.tp[32] * 4, full = (TOT / C.nblk) * C.nblk;
    {
        MoeOrder S; S.vcu = C.vcu; S.nblk = C.nblk; S.full = full; S.tp = M.tp; S.cnt = M.cnt; S.off = M.off;
        EpiMoe1 E; E.ws = C.ws; E.layer = layer;
        pg8::gemm_phase((LAS unsigned char*)C.lds, D, S, E, C.tid);
    }
    for (int w2 = C.vcu; w2 < 2 * (TOT - full); w2 += C.nblk) {
        const int w = full + (w2 >> 1);
        moe1_tile<2>(C, layer, M, w >> 2, 2 * (w & 3) + (w2 & 1));
    }
}

template <int NMI>
__device__ __forceinline__ void moe2_tile(const Ctx& C, int layer, const MoeTab& M, int ttile, int nt  ) {
    const int tid = C.tid, lane = C.lane, wid = C.wid, r32 = lane & 31, hi = lane >> 5, wn = wid >> 2, wt = wid & 3;
    const bf16_t* hb = WSP(bf16_t, WS_HB); bf16_t* yb = WSP(bf16_t, WS_YB);
    const int c = GEMM_SRC_CHUNK(tid), r0 = tid >> 3;
    int e = 0;
    for (int k = 1; k < 32; ++k) if (M.tp[k] <= ttile) e = k;
    const int lt = ttile - M.tp[e], cnt = M.cnt[e];
    const bf16_t* rp[NMI + 4];
#pragma unroll
    for (int i = 0; i < NMI; ++i) rp[i] = WSP(bf16_t, WS_W2) + ((size_t)(layer * 32 + e) * 1024 + nt * (NMI * 64) + r0 + 64 * i) * 512 + c * 8;
#pragma unroll
    for (int i = 0; i < 4; ++i) {
        int slot = lt * 256 + r0 + 64 * i; slot = slot < cnt ? slot : cnt - 1;
        rp[NMI + i] = hb + (size_t)(M.off[e] + slot) * 512 + c * 8;
    }
    f32x16 acc[NMI][2];
    gemm_core<8, NMI, true>(C.lds, rp, acc, tid, cnt - lt * 256 < 256 ? cnt - lt * 256 : 256);
    char* wbuf = C.lds + wid * WStage<NMI * 32>::BYTES;
#pragma unroll
    for (int ti = 0; ti < 2; ++ti)
#pragma unroll
        for (int mi = 0; mi < NMI; ++mi)
#pragma unroll
            for (int g4 = 0; g4 < 4; ++g4) {
                u32x2 o; o.x = cvtpk(acc[mi][ti][4 * g4], acc[mi][ti][4 * g4 + 1]); o.y = cvtpk(acc[mi][ti][4 * g4 + 2], acc[mi][ti][4 * g4 + 3]);
                stage_put<NMI * 32>(wbuf, ti * 32 + r32, mi * 32 + 8 * g4 + 4 * hi, o);
            }
    stage_flush<NMI * 32>(wbuf, lane, yb + (size_t)(M.off[e] + lt * 256 + wt * 64) * D + nt * (NMI * 64) + wn * (NMI * 32), D, cnt - (lt * 256 + wt * 64));
    __syncthreads();
}
struct EpiMoe2 {
    static constexpr bool GATHER = false;
    static __device__ __forceinline__ size_t bstep(int K) { return (size_t)128 * K * 2; }
    static __device__ __forceinline__ int brow(int R) { return (R & ~31) + pg8::perm32(R & 31); }
    unsigned char* ws; int layer;
    __device__ __forceinline__ const char* A(const pg8::Unit& u) const { return (const char*)(ws + WS_HB) + (size_t)u.row0 * (512 * 2); }
    __device__ __forceinline__ const char* B(const pg8::Unit& u) const { return (const char*)(ws + WS_W2) + ((size_t)(layer * 32 + u.e) * 1024 + u.pn * 256) * (512 * 2); }
    __device__ __forceinline__ void init(f32x4 (&acc)[2][2][4][2], const pg8::Unit&, int, int, int, int) const {
#pragma unroll
        for (int a = 0; a < 2; ++a)
#pragma unroll
            for (int b = 0; b < 2; ++b)
#pragma unroll
                for (int m = 0; m < 4; ++m)
#pragma unroll
                    for (int n = 0; n < 2; ++n) acc[a][b][m][n] = (f32x4){0.f, 0.f, 0.f, 0.f};
    }
    __device__ __forceinline__ void operator()(const f32x4 (&acc)[2][2][4][2], const pg8::Unit& u, int wr, int wc, int fr, int fq, bool wt) const {
        bf16_t* yb = (bf16_t*)(ws + WS_YB);
        const int nval = u.cnt - u.lt * 256;
#pragma unroll
        for (int ai = 0; ai < 2; ++ai)
#pragma unroll
            for (int m = 0; m < 4; ++m) { const int r = ai * 128 + wr * 64 + m * 16 + fr;
                if (r < nval) { bf16_t* rowp = yb + (size_t)(u.row0 + r) * D + u.pn * 256 + wc * 32 + 8 * fq;
#pragma unroll
                    for (int bj = 0; bj < 2; ++bj) { const f32x4 v0 = acc[ai][bj][m][0], v1 = acc[ai][bj][m][1];
                        u32x4 w; w.x = cvtpk(v0[0], v0[1]); w.y = cvtpk(v0[2], v0[3]); w.z = cvtpk(v1[0], v1[1]); w.w = cvtpk(v1[2], v1[3]);
                        st16_sel(rowp + bj * 128, w, wt); } } }
    }
};
__device__ __forceinline__ void phase_moe2(const Ctx& C, int layer) {
    const MoeTab M = moe_tables(C, layer, GEMM_LDS, false);
    const int TOT = M.tp[32] * 4, full = (TOT / C.nblk) * C.nblk;
    {
        MoeOrder S; S.vcu = C.vcu; S.nblk = C.nblk; S.full = full; S.tp = M.tp; S.cnt = M.cnt; S.off = M.off;
        EpiMoe2 E; E.ws = C.ws; E.layer = layer;
        pg8::gemm_phase((LAS unsigned char*)C.lds, 512, S, E, C.tid);
    }
    for (int w2 = C.vcu; w2 < 2 * (TOT - full); w2 += C.nblk) {
        const int w = full + (w2 >> 1);
        moe2_tile<2>(C, layer, M, w >> 2, 2 * (w & 3) + (w2 & 1));
    }
}

__device__ __forceinline__ void phase_final(const Ctx& C, int layer) {
    const int lane = C.lane;
    const MoeTab M = moe_tables(C, layer, GEMM_LDS, false);
    float* H = WSP(float, WS_H); const bf16_t* yb = WSP(bf16_t, WS_YB); const int* tokinfo = WSP(int, WS_TOK);
    bf16_t* act = WSP(bf16_t, WS_ACT);
    const float* lng = C.in[6] + (size_t)(layer * 2 + 1) * D; const float* lnb = C.in[7] + (size_t)(layer * 2 + 1) * D;
    const float* lng1 = C.in[6] + (size_t)(layer * 2 + 0) * D; const float* lnb1 = C.in[7] + (size_t)(layer * 2 + 0) * D;
    const int T = layer == 0 ? R : NB * SEQ;
    for (int tk = C.bid * 8 + C.wid; tk < T; tk += C.nblk * 8) {
        const int row = moe_row(layer, tk), set = row_set(row);
        const int* ti = tokinfo + (size_t)row * 8;
        const int e0 = ti[0], s0 = ti[1], e1 = ti[2], s1 = ti[3]; const float w0 = __int_as_float(ti[4]), w1 = __int_as_float(ti[5]);
        const float mu1 = __int_as_float(ti[6]), rs1 = __int_as_float(ti[7]);
        const bf16_t* y0 = yb + (size_t)(M.off[e0] + s0) * D; const bf16_t* y1 = yb + (size_t)(M.off[e1] + s1) * D;
        const float* m = WSP(float, WS_MODS) + (size_t)(layer * 3 + set) * 6144;
        float* hr = H + (size_t)row * D;
        f32x4 x[4]; float s = 0.f, q = 0.f;
#pragma unroll
        for (int i = 0; i < 4; ++i) {
            const int col = lane * 4 + 256 * i;
            const f32x4 hv = (*(const f32x4*)(hr + col) - mu1) * rs1 * *(const f32x4*)(lng1 + col) + *(const f32x4*)(lnb1 + col), g5 = *(const f32x4*)(m + 5 * 1024 + col);
            const u32x2 a = *(const u32x2*)(y0 + col), b = *(const u32x2*)(y1 + col);
            f32x4 y;
            y[0] = w0 * bf2f((unsigned short)(a.x & 0xffff)) + w1 * bf2f((unsigned short)(b.x & 0xffff)); y[1] = w0 * bf2f((unsigned short)(a.x >> 16)) + w1 * bf2f((unsigned short)(b.x >> 16));
            y[2] = w0 * bf2f((unsigned short)(a.y & 0xffff)) + w1 * bf2f((unsigned short)(b.y & 0xffff)); y[3] = w0 * bf2f((unsigned short)(a.y >> 16)) + w1 * bf2f((unsigned short)(b.y >> 16));
            x[i] = ALPHA * hv + g5 * y;
            s += (x[i][0] + x[i][1]) + (x[i][2] + x[i][3]); q += (x[i][0] * x[i][0] + x[i][1] * x[i][1]) + (x[i][2] * x[i][2] + x[i][3] * x[i][3]);
        }
        wave_sum2(s, q, lane);
        const float mean = s * (1.f / 1024.f);
        const float rstd = rsqrtf(fmaxf(q * (1.f / 1024.f) - mean * mean, 0.f) + 1e-5f);
#pragma unroll
        for (int i = 0; i < 4; ++i) x[i] -= mean;
        const float* mn = WSP(float, WS_MODS) + (size_t)(3 + set) * 6144;
        u32x2 ob[4];
#pragma unroll
        for (int i = 0; i < 4; ++i) {
            const int col = lane * 4 + 256 * i;
            const f32x4 g = *(const f32x4*)(lng + col), bb = *(const f32x4*)(lnb + col);
            const f32x4 hv = x[i] * rstd * g + bb;
            if (layer == 0) {
                st16_wt(hr + col, __builtin_bit_cast(u32x4, hv));
                const f32x4 sh = *(const f32x4*)(mn + col), sc = *(const f32x4*)(mn + 1024 + col);
                const f32x4 a = hv * (1.f + sc) + sh;
                ob[i].x = cvtpk(a[0], a[1]); ob[i].y = cvtpk(a[2], a[3]);
            } else {
                *(f32x4*)(C.out + (size_t)tk * D + col) = hv;
            }
        }
        if (layer == 0) store_row_bf16(act + (size_t)row * D, lane, ob);
    }
}

constexpr int NPHASE = 17;
#ifndef REPEAT_PH
#define REPEAT_PH -1
#endif
#define PH_REP(k) ((k) == REPEAT_PH)
#ifndef PH_ONLY
#define PH_EN(k) true
#else
#define PH_EN(k) ((k) == PH_ONLY)
#endif
__global__ void __launch_bounds__(NTHR, 2) mega(Args args) {
    extern __shared__ __attribute__((aligned(16))) char lds[];
    Ctx CB; CB.lds = lds; CB.tid = threadIdx.x; CB.lane = CB.tid & 63; CB.wid = __builtin_amdgcn_readfirstlane(CB.tid >> 6);
    CB.bid = blockIdx.x; CB.nblk = gridDim.x; CB.vcu = blockIdx.x; CB.in = args.in; CB.out = args.out; CB.ws = args.ws;
    const Ctx& C = CB;
    volatile LAS unsigned* bst = (volatile LAS unsigned*)(LAS char*)(lds + LDS_BYTES - 64);
    if (CB.tid < 4) bst[CB.tid] = 0u;
    __syncthreads();
#if MK_SINGLE
    constexpr bool single = true;
#else
    const bool single = (args.ph_hi - args.ph_lo) > 1;
#endif
    XcdBarrier bar; bar.bar = (unsigned*)(C.ws + WS_CTL) + CW_BAR; bar.x = 0; bar.st = bst;
    if (single) bar = xcd_barrier_post((unsigned*)(C.ws + WS_CTL) + CW_BAR, bst);
#if MK_SINGLE
    constexpr int lo = 0, hi = NPHASE;
#else
    const int lo = args.ph_lo, hi = args.ph_hi;
#endif
#define RUN(k, call) if (lo <= (k) && (k) < hi) { Ctx C = CB; asm volatile("" : "+v"(C.tid)); C.lane = C.tid & 63; C.wid = __builtin_amdgcn_readfirstlane(C.tid >> 6); if (PH_EN(k)) { call; } if (PH_REP(k)) { __syncthreads(); call; } if (single && (k) + 1 < hi) xcd_barrier(bar); else __syncthreads(); }
    RUN(0, phase_prologue(C))
    if (single && lo == 0) {
        if (CB.tid == 0) {
            unsigned base = 0;
            for (unsigned j = 0; j < 16; ++j) { const unsigned c = xb_ld(&bar.bar[XB_XCNT(j)]); if (j < bar.x) base += c; }
            bst[3] = base + bst[2];
        }
        __syncthreads();
        const unsigned v = bst[3];
        CB.vcu = __builtin_amdgcn_readfirstlane(v < (unsigned)CB.nblk ? (int)v : CB.bid);
    }
    RUN(1, phase_mod0(C))
    RUN(2, phase_proj(C, 0))
    RUN(3, phase_attn0(C))
    RUN(4, phase_merge0(C))
    RUN(5, phase_out(C, 0))
    RUN(6, phase_route(C, 0))
    RUN(7, phase_moe1(C, 0))
    RUN(8, phase_moe2(C, 0))
    RUN(9, phase_final(C, 0))
    RUN(10, phase_proj(C, 1))
    RUN(11, phase_attn1(C))
    RUN(12, phase_out(C, 1))
    RUN(13, phase_route(C, 1))
    RUN(14, phase_moe1(C, 1))
    RUN(15, phase_moe2(C, 1))
    RUN(16, phase_final(C, 1))
#undef RUN
}

extern "C" void kernel_launch(void* const* d_in, const int* in_sizes, int n_in, void* d_out, int out_size, void* d_ws, size_t ws_size, hipStream_t stream) {
    static int grid = 0;
    if (grid == 0) {
        if (n_in != 24 || ws_size < WS_END) { fprintf(stderr, "kernel_launch: unexpected n_in %d / ws_size %zu (need %zu)\n", n_in, ws_size, (size_t)WS_END); grid = -1; return; }
        int dev = 0, cus = 0, per_cu = 0;
        hipGetDevice(&dev);
        hipDeviceGetAttribute(&cus, hipDeviceAttributeMultiprocessorCount, dev);
        hipFuncSetAttribute((const void*)mega, hipFuncAttributeMaxDynamicSharedMemorySize, LDS_BYTES);
        hipOccupancyMaxActiveBlocksPerMultiprocessor(&per_cu, (const void*)mega, NTHR, LDS_BYTES);
        (void)hipGetLastError();
        if (per_cu < 1) fprintf(stderr, "kernel_launch: occupancy query says %d blocks/CU\n", per_cu);
        grid = cus;
    }
    if (grid < 0) return;
    hipMemsetAsync((char*)d_ws + WS_CTL, 0, CTL_BYTES, stream);
    Args a{};
    for (int i = 0; i < 24; ++i) a.in[i] = (const float*)d_in[i];
    a.out = (float*)d_out; a.ws = (unsigned char*)d_ws;
#if MK_SINGLE
    a.ph_lo = 0; a.ph_hi = NPHASE;
    void* kargs[] = {&a};
    hipLaunchCooperativeKernel((const void*)mega, dim3(grid), dim3(NTHR), kargs, LDS_BYTES, stream);
#else
    for (int ph = 0; ph < NPHASE; ++ph) {
        a.ph_lo = ph; a.ph_hi = ph + 1;
        hipLaunchKernelGGL(mega, dim3(grid), dim3(NTHR), LDS_BYTES, stream, a);
    }
#endif
}
```
